# Optimizing an MI355X kernel written in HIP

```python
import jax, jax.numpy as jnp
from jax import lax
import numpy as np

D_MODEL = 1024
BATCH = 4
SEQ = 8192
DEPTH = 1

PLE_DIM = 256
HEAD_DIM = 64
N_ATTN_HEADS = 8
ATTN_WIDTH = N_ATTN_HEADS * HEAD_DIM
CONV_WIDTH = D_MODEL - ATTN_WIDTH
N_CONV_GROUPS = 8
CONV_GROUP_DIM = CONV_WIDTH // N_CONV_GROUPS
MIX_WIDTH = ATTN_WIDTH + CONV_WIDTH
CONV_K = 3
DILATED_GROUPS = ((128, 1), (512, 4), (2048, 16))
ATTN_BLOCK = 128
ROPE_THETA = 500000.0
ROPE_DIM = HEAD_DIM // 4
N_GROUPS = 4
EXPERTS_PER_GROUP = 4
N_EXPERTS = N_GROUPS * EXPERTS_PER_GROUP
TOP_K = 2
D_FF_EXPERT = 512
EPS = 1e-6

kernel_name = "hymba_conv_dilated_attn_hmoe_ple"


def rmsnorm(x, g):
    x32 = x.astype(jnp.float32)
    y = x32 * lax.rsqrt(jnp.mean(x32 * x32, axis=-1, keepdims=True) + EPS)
    return (y * g.astype(jnp.float32)).astype(x.dtype)


def partial_rope(x, pos):
    half = ROPE_DIM // 2
    inv = ROPE_THETA ** (-jnp.arange(0, ROPE_DIM, 2, dtype=jnp.float32) / ROPE_DIM)
    ang = pos.astype(jnp.float32)[:, None] * inv[None, :]
    cos = jnp.cos(ang)[None, :, None, :]
    sin = jnp.sin(ang)[None, :, None, :]
    x32 = x.astype(jnp.float32)
    x1 = x32[..., :half]
    x2 = x32[..., half:ROPE_DIM]
    rot = jnp.concatenate([x1 * cos - x2 * sin, x2 * cos + x1 * sin], axis=-1).astype(x.dtype)
    return jnp.concatenate([rot, x[..., ROPE_DIM:]], axis=-1)


def dilated_window_branch(q, k, v, window, dilation):
    B, S, H, Dh = q.shape
    n_back = window // dilation
    L = S // dilation
    nb = -(-L // ATTN_BLOCK)
    Lp = nb * ATTN_BLOCK

    def split(t):
        t = t.reshape(B, L, dilation, H, Dh)
        t = jnp.pad(t, ((0, 0), (0, Lp - L), (0, 0), (0, 0), (0, 0)))
        return t.reshape(B, nb, ATTN_BLOCK, dilation, H, Dh)

    def with_prev(t):
        prev = jnp.pad(t, ((0, 0), (1, 0), (0, 0), (0, 0), (0, 0), (0, 0)))[:, :-1]
        return jnp.concatenate([prev, t], axis=2)

    qb = split(q)
    kk = with_prev(split(k))
    vv = with_prev(split(v))
    s = jnp.einsum('bnqrhd,bnkrhd->bnrhqk', qb, kk,
                   preferred_element_type=jnp.float32)
    qi = jnp.arange(ATTN_BLOCK)[:, None]
    ki = jnp.arange(2 * ATTN_BLOCK)[None, :]
    dist = qi + ATTN_BLOCK - ki
    band = (dist >= 0) & (dist <= n_back)
    exists = (jnp.arange(nb)[:, None, None] > 0) | (ki[None] >= ATTN_BLOCK)
    valid = band[None] & exists
    s = jnp.where(valid[None, :, None, None], s, -jnp.inf)
    m = jnp.max(s, axis=-1)
    e = jnp.exp(s - m[..., None])
    den = jnp.sum(e, axis=-1)
    num = jnp.einsum('bnrhqk,bnkrhd->bnqrhd', e, vv.astype(jnp.float32))
    num = num.reshape(B, Lp, dilation, H, Dh)[:, :L].reshape(B, S, H, Dh)

    def unblock(t):
        t = t.transpose(0, 1, 4, 2, 3).reshape(B, Lp, dilation, H)
        return t[:, :L].reshape(B, S, H)

    return num, unblock(m), unblock(den)


def dilated_mixture_attention(q, k, v):
    parts = [dilated_window_branch(q, k, v, w, d) for (w, d) in DILATED_GROUPS]
    m_all = jnp.max(jnp.stack([pm for (_, pm, _) in parts], axis=0), axis=0)
    num = 0.0
    den = 0.0
    for (pn, pm, pd) in parts:
        w = jnp.exp(pm - m_all)
        num = num + w[..., None] * pn
        den = den + w * pd
    return num / den[..., None]


def short_gated_conv(b_gate, c_gate, hx, w):
    u = c_gate * hx
    y = lax.conv_general_dilated(
        u, w[:, None, :].astype(u.dtype), window_strides=(1,),
        padding=((CONV_K - 1, 0),), dimension_numbers=('NWC', 'WIO', 'NWC'),
        feature_group_count=u.shape[-1])
    return b_gate * y


def hierarchical_moe(x, w_rg, b_rg, w_re, b_re, w1, w3, w2):
    B, S, _ = x.shape
    lg = jnp.einsum('bsd,dg->bsg', x, w_rg, preferred_element_type=jnp.float32) + b_rg.astype(jnp.float32)
    pg = jax.nn.softmax(lg, axis=-1)
    g_idx = jnp.argmax(lg, axis=-1)
    pg_top = jnp.take_along_axis(pg, g_idx[..., None], axis=-1)
    le = jnp.einsum('bsd,de->bse', x, w_re, preferred_element_type=jnp.float32) + b_re.astype(jnp.float32)
    le = le.reshape(B, S, N_GROUPS, EXPERTS_PER_GROUP)
    le_sel = jnp.take_along_axis(le, g_idx[..., None, None], axis=-2)[..., 0, :]
    pe = jax.nn.softmax(le_sel, axis=-1)
    tv, ti = lax.top_k(pe, TOP_K)
    tv = tv / jnp.sum(tv, axis=-1, keepdims=True)
    within = jnp.sum(jax.nn.one_hot(ti, EXPERTS_PER_GROUP, dtype=jnp.float32) * tv[..., None], axis=-2)
    gates = (pg_top[..., None]
             * jax.nn.one_hot(g_idx, N_GROUPS, dtype=jnp.float32)[..., None]
             * within[..., None, :]).reshape(B, S, N_EXPERTS).astype(x.dtype)
    y = jnp.zeros_like(x)
    for e in range(N_EXPERTS):
        hdn = jax.nn.silu(x @ w1[e]) * (x @ w3[e])
        y = y + gates[..., e:e + 1] * (hdn @ w2[e])
    return y


def setup_inputs(seed: int = 0) -> dict:
    key = jax.random.key(seed)
    ks = jax.random.split(key, 24)
    f32 = jnp.float32

    def nrm(k, shape, fan_in):
        return jax.random.normal(k, shape, f32) * (fan_in ** -0.5)

    def gain(k, shape):
        return 1.0 + 0.05 * jax.random.normal(k, shape, f32)

    n_in = 3 * ATTN_WIDTH + 3 * CONV_WIDTH
    return {
        "x": jax.random.normal(ks[0], (BATCH, SEQ, D_MODEL), f32),
        "p": jax.random.normal(ks[1], (DEPTH, BATCH, SEQ, PLE_DIM), f32),
        "g_mix": gain(ks[2], (DEPTH, D_MODEL)),
        "w_in": nrm(ks[3], (DEPTH, D_MODEL, n_in), D_MODEL),
        "q_norm": gain(ks[4], (DEPTH, HEAD_DIM)),
        "k_norm": gain(ks[5], (DEPTH, HEAD_DIM)),
        "conv_w": nrm(ks[6], (DEPTH, CONV_K, CONV_WIDTH), CONV_K),
        "g_attn_out": gain(ks[7], (DEPTH, ATTN_WIDTH)),
        "g_conv_out": gain(ks[8], (DEPTH, CONV_WIDTH)),
        "w_out": nrm(ks[9], (DEPTH, MIX_WIDTH, D_MODEL), MIX_WIDTH),
        "g_ffn": gain(ks[10], (DEPTH, D_MODEL)),
        "w_router_group": nrm(ks[11], (DEPTH, D_MODEL, N_GROUPS), D_MODEL),
        "b_router_group": 0.01 * jax.random.normal(ks[12], (DEPTH, N_GROUPS), f32),
        "w_router_expert": nrm(ks[13], (DEPTH, D_MODEL, N_EXPERTS), D_MODEL),
        "b_router_expert": 0.01 * jax.random.normal(ks[14], (DEPTH, N_EXPERTS), f32),
        "w1": nrm(ks[15], (DEPTH, N_EXPERTS, D_MODEL, D_FF_EXPERT), D_MODEL),
        "w3": nrm(ks[16], (DEPTH, N_EXPERTS, D_MODEL, D_FF_EXPERT), D_MODEL),
        "w2": nrm(ks[17], (DEPTH, N_EXPERTS, D_FF_EXPERT, D_MODEL), D_FF_EXPERT),
        "g_ple": gain(ks[18], (DEPTH, D_MODEL)),
        "w_ple_gate": nrm(ks[19], (DEPTH, D_MODEL, D_MODEL), D_MODEL),
        "w_ple_proj": nrm(ks[20], (DEPTH, PLE_DIM, D_MODEL), PLE_DIM),
        "g_ple_post": gain(ks[21], (DEPTH, D_MODEL)),
    }


def reference(x, p, g_mix, w_in, q_norm, k_norm, conv_w, g_attn_out, g_conv_out, w_out,
              g_ffn, w_router_group, b_router_group, w_router_expert, b_router_expert,
              w1, w3, w2, g_ple, w_ple_gate, w_ple_proj, g_ple_post):
    B, S, _ = x.shape
    pos = jnp.arange(S)
    A, C = ATTN_WIDTH, CONV_WIDTH
    h = x
    for i in range(DEPTH):
        xn = rmsnorm(h, g_mix[i])
        z = xn @ w_in[i]
        q, k, v, cb, cc, ch = jnp.split(z, [A, 2 * A, 3 * A, 3 * A + C, 3 * A + 2 * C], axis=-1)
        q = q.reshape(B, S, N_ATTN_HEADS, HEAD_DIM)
        k = k.reshape(B, S, N_ATTN_HEADS, HEAD_DIM)
        v = v.reshape(B, S, N_ATTN_HEADS, HEAD_DIM)
        q = partial_rope(rmsnorm(q, q_norm[i]), pos) * (HEAD_DIM ** -0.5)
        k = partial_rope(rmsnorm(k, k_norm[i]), pos)
        attn = dilated_mixture_attention(q, k, v).astype(h.dtype)
        attn = rmsnorm(attn, g_attn_out[i].reshape(N_ATTN_HEADS, HEAD_DIM)).reshape(B, S, A)
        conv = short_gated_conv(cb, cc, ch, conv_w[i])
        conv = rmsnorm(conv.reshape(B, S, N_CONV_GROUPS, CONV_GROUP_DIM),
                       g_conv_out[i].reshape(N_CONV_GROUPS, CONV_GROUP_DIM)).reshape(B, S, C)
        h = h + jnp.concatenate([attn, conv], axis=-1) @ w_out[i]
        h = h + hierarchical_moe(rmsnorm(h, g_ffn[i]), w_router_group[i], b_router_group[i],
                                 w_router_expert[i], b_router_expert[i], w1[i], w3[i], w2[i])
        gate = jax.nn.sigmoid(rmsnorm(h, g_ple[i]) @ w_ple_gate[i])
        h = h + gate * rmsnorm(p[i] @ w_ple_proj[i], g_ple_post[i])
    return h
```

```cpp
#include <hip/hip_runtime.h>
#include <stdint.h>
#include <math.h>

typedef float f32x16 __attribute__((ext_vector_type(16)));
typedef float f32x4 __attribute__((ext_vector_type(4)));

constexpr int T = 32768, DM = 1024, SEQ = 8192, NZ = 3072, NH = 8, HD = 64, PLE = 256, FF = 512;
constexpr int PAD = 64;
constexpr int NBKT = 24;
constexpr int MAXSR = T + NBKT * 256;
constexpr float EPS = 1e-6f;
constexpr size_t MiB = 1u << 20;

struct P {
    const float *x, *p, *g_mix, *w_in, *q_norm, *k_norm, *conv_w, *g_attn_out, *g_conv_out, *w_out, *g_ffn, *w_rg, *b_rg, *w_re, *b_re,
        *w1, *w3, *w2, *g_ple, *w_ple_gate, *w_ple_proj, *g_ple_post;
    float* out;
    float *xn, *z, *mix, *h1, *xf, *H, *u, *xg;
    int* cnt; int* list; float* tok_ga; float* tok_gb; int* srow_tok; float* srow_ga; float* srow_gb;
    float inv_freq[8];
};

__device__ __forceinline__ float wave_sum(float v) {
#pragma unroll
    for (int o = 1; o < 64; o <<= 1) v += __shfl_xor(v, o);
    return v;
}

__device__ __forceinline__ void rms_row1024(const float* src, const float* gain, float* dst, int lane) {
    const f32x4* s = (const f32x4*)src; f32x4 v[4]; float ss = 0.f;
#pragma unroll
    for (int j = 0; j < 4; ++j) { v[j] = s[lane + 64 * j]; ss += v[j].x * v[j].x + v[j].y * v[j].y + v[j].z * v[j].z + v[j].w * v[j].w; }
    ss = wave_sum(ss);
    const float r = 1.0f / sqrtf(ss * (1.0f / 1024.f) + EPS);
#pragma unroll
    for (int j = 0; j < 4; ++j) { const f32x4 g = ((const f32x4*)gain)[lane + 64 * j]; ((f32x4*)dst)[lane + 64 * j] = v[j] * r * g; }
}
__global__ void __launch_bounds__(512) k_rms(const float* src, const float* gain, float* dst) {
    const int lane = threadIdx.x & 63, gw = blockIdx.x * 8 + (threadIdx.x >> 6), ngw = gridDim.x * 8;
    for (int r = gw; r < T; r += ngw) rms_row1024(src + (size_t)r * DM, gain, dst + (size_t)r * DM, lane);
}

template <bool DUAL, class F>
__device__ __forceinline__ void gemm64(F& f, int gw, int ngw, int lane) {
    const int i = lane & 31, h = lane >> 5;
    const int M = f.M();
    constexpr int N = F::N, K = F::K;
    constexpr int ntn = N / 64;
    const int ntiles = (M / 64) * ntn;
    for (int tile = gw; tile < ntiles; tile += ngw) {
        const int tm = tile / ntn, tn = tile % ntn;
        f.setup(tm, tn);
        f32x16 acc[2][2], acc2[2][2];
#pragma unroll
        for (int a = 0; a < 2; ++a)
#pragma unroll
            for (int b = 0; b < 2; ++b)
#pragma unroll
                for (int r = 0; r < 16; ++r) { acc[a][b][r] = 0.f; acc2[a][b][r] = 0.f; }
        const float* ar0 = f.a_row(tm * 64 + i) + 4 * h;
        const float* ar1 = f.a_row(tm * 64 + 32 + i) + 4 * h;
        const int ldb = f.ldb();
#pragma unroll 2
        for (int k0 = 0; k0 < K; k0 += 8) {
            const f32x4 a0 = *(const f32x4*)(ar0 + k0), a1 = *(const f32x4*)(ar1 + k0);
            const float* bp = f.b_ptr(k0 + 4 * h, tn * 64 + i);
            float b0[4], b1[4];
#pragma unroll
            for (int s = 0; s < 4; ++s) { b0[s] = bp[(size_t)s * ldb]; b1[s] = bp[(size_t)s * ldb + 32]; }
#pragma unroll
            for (int s = 0; s < 4; ++s) {
                acc[0][0] = __builtin_amdgcn_mfma_f32_32x32x2f32(a0[s], b0[s], acc[0][0], 0, 0, 0);
                acc[0][1] = __builtin_amdgcn_mfma_f32_32x32x2f32(a0[s], b1[s], acc[0][1], 0, 0, 0);
                acc[1][0] = __builtin_amdgcn_mfma_f32_32x32x2f32(a1[s], b0[s], acc[1][0], 0, 0, 0);
                acc[1][1] = __builtin_amdgcn_mfma_f32_32x32x2f32(a1[s], b1[s], acc[1][1], 0, 0, 0);
            }
            if constexpr (DUAL) {
                const float* bq = f.b2_ptr(k0 + 4 * h, tn * 64 + i);
                float c0[4], c1[4];
#pragma unroll
                for (int s = 0; s < 4; ++s) { c0[s] = bq[(size_t)s * ldb]; c1[s] = bq[(size_t)s * ldb + 32]; }
#pragma unroll
                for (int s = 0; s < 4; ++s) {
                    acc2[0][0] = __builtin_amdgcn_mfma_f32_32x32x2f32(a0[s], c0[s], acc2[0][0], 0, 0, 0);
                    acc2[0][1] = __builtin_amdgcn_mfma_f32_32x32x2f32(a0[s], c1[s], acc2[0][1], 0, 0, 0);
                    acc2[1][0] = __builtin_amdgcn_mfma_f32_32x32x2f32(a1[s], c0[s], acc2[1][0], 0, 0, 0);
                    acc2[1][1] = __builtin_amdgcn_mfma_f32_32x32x2f32(a1[s], c1[s], acc2[1][1], 0, 0, 0);
                }
            }
        }
#pragma unroll
        for (int a = 0; a < 2; ++a)
#pragma unroll
            for (int b = 0; b < 2; ++b)
#pragma unroll
                for (int r = 0; r < 16; ++r) {
                    const int row = tm * 64 + a * 32 + (r & 3) + 8 * (r >> 2) + 4 * h, col = tn * 64 + b * 32 + i;
                    f.store(row, col, acc[a][b][r], acc2[a][b][r]);
                }
    }
}

struct FZ { static constexpr int N = NZ, K = DM; const P* p;
    __device__ int M() const { return T; } __device__ void setup(int, int) {} __device__ int ldb() const { return NZ; }
    __device__ const float* a_row(int r) const { return p->xn + (size_t)r * DM; }
    __device__ const float* b_ptr(int k, int c) const { return p->w_in + (size_t)k * NZ + c; }
    __device__ const float* b2_ptr(int, int) const { return nullptr; }
    __device__ void store(int r, int c, float v, float) const { p->z[(size_t)r * NZ + c] = v; } };
struct FO { static constexpr int N = DM, K = DM; const P* p;
    __device__ int M() const { return T; } __device__ void setup(int, int) {} __device__ int ldb() const { return DM; }
    __device__ const float* a_row(int r) const { return p->mix + (size_t)r * DM; }
    __device__ const float* b_ptr(int k, int c) const { return p->w_out + (size_t)k * DM + c; }
    __device__ const float* b2_ptr(int, int) const { return nullptr; }
    __device__ void store(int r, int c, float v, float) const { p->h1[(size_t)r * DM + c] = p->x[(size_t)r * DM + c] + v; } };
__device__ __forceinline__ void bucket_of(const int* cnt, int sr, int& bsel, int& base, int& total) {
    int o = 0; bsel = -1; base = 0;
#pragma unroll
    for (int b = 0; b < NBKT; ++b) { const int n = cnt[b], np = (n + PAD - 1) / PAD * PAD; if (sr >= o && sr < o + np) { bsel = b; base = o; } o += np; }
    total = o;
}
__device__ __forceinline__ void bucket_experts(int b, int& ea, int& eb) {
    const int g = b / 6, pi = b % 6;
    const int a = pi < 3 ? 0 : (pi < 5 ? 1 : 2);
    const int bb = pi < 3 ? pi + 1 : (pi < 5 ? pi - 1 : 3);
    ea = g * 4 + a; eb = g * 4 + bb;
}
struct FM1 { static constexpr int N = 1024, K = DM; const P* p; int total, ea, eb, e, slot;
    __device__ int M() const { return total; }
    __device__ void setup(int tm, int tn) { int b, base, tot; bucket_of(p->cnt, tm * 64, b, base, tot); if (b < 0) b = 0; bucket_experts(b, ea, eb); slot = (tn * 64) >> 9; e = slot ? eb : ea; }
    __device__ int ldb() const { return FF; }
    __device__ const float* a_row(int r) const { int t = p->srow_tok[r]; if (t < 0) t = 0; return p->xf + (size_t)t * DM; }
    __device__ const float* b_ptr(int k, int c) const { return p->w1 + ((size_t)e * DM + k) * FF + (c & 511); }
    __device__ const float* b2_ptr(int k, int c) const { return p->w3 + ((size_t)e * DM + k) * FF + (c & 511); }
    __device__ void store(int r, int c, float u, float v) const {
        const float gate = slot ? p->srow_gb[r] : p->srow_ga[r];
        const float s = u / (1.0f + expf(-u));
        p->H[(size_t)r * 1024 + c] = gate * s * v; } };
struct FM2 { static constexpr int N = DM, K = 1024; const P* p; int total, ea, eb;
    __device__ int M() const { return total; }
    __device__ void setup(int tm, int) { int b, base, tot; bucket_of(p->cnt, tm * 64, b, base, tot); if (b < 0) b = 0; bucket_experts(b, ea, eb); }
    __device__ int ldb() const { return DM; }
    __device__ const float* a_row(int r) const { return p->H + (size_t)r * 1024; }
    __device__ const float* b_ptr(int k, int c) const { const int e = k < 512 ? ea : eb; return p->w2 + ((size_t)e * FF + (k & 511)) * DM + c; }
    __device__ const float* b2_ptr(int, int) const { return nullptr; }
    __device__ void store(int r, int c, float v, float) const { const int t = p->srow_tok[r]; if (t >= 0) p->out[(size_t)t * DM + c] = p->h1[(size_t)t * DM + c] + v; } };
struct FU { static constexpr int N = DM, K = PLE; const P* p;
    __device__ int M() const { return T; } __device__ void setup(int, int) {} __device__ int ldb() const { return DM; }
    __device__ const float* a_row(int r) const { return p->p + (size_t)r * PLE; }
    __device__ const float* b_ptr(int k, int c) const { return p->w_ple_proj + (size_t)k * DM + c; }
    __device__ const float* b2_ptr(int, int) const { return nullptr; }
    __device__ void store(int r, int c, float v, float) const { p->u[(size_t)r * DM + c] = v; } };
struct FG { static constexpr int N = DM, K = DM; const P* p;
    __device__ int M() const { return T; } __device__ void setup(int, int) {} __device__ int ldb() const { return DM; }
    __device__ const float* a_row(int r) const { return p->xg + (size_t)r * DM; }
    __device__ const float* b_ptr(int k, int c) const { return p->w_ple_gate + (size_t)k * DM + c; }
    __device__ const float* b2_ptr(int, int) const { return nullptr; }
    __device__ void store(int r, int c, float v, float) const { const size_t o = (size_t)r * DM + c; const float g = 1.0f / (1.0f + expf(-v)); p->out[o] = p->out[o] + g * p->u[o]; } };

template <int WHICH> __global__ void __launch_bounds__(512) k_gemm(P p) {
    const int lane = threadIdx.x & 63, gw = blockIdx.x * 8 + (threadIdx.x >> 6), ngw = gridDim.x * 8;
    if constexpr (WHICH == 1) { FZ f{&p}; gemm64<false>(f, gw, ngw, lane); }
    if constexpr (WHICH == 2) { FO f{&p}; gemm64<false>(f, gw, ngw, lane); }
    if constexpr (WHICH == 3) { FM1 f{&p}; int b, base; bucket_of(p.cnt, -1, b, base, f.total); gemm64<true>(f, gw, ngw, lane); }
    if constexpr (WHICH == 4) { FM2 f{&p}; int b, base; bucket_of(p.cnt, -1, b, base, f.total); gemm64<false>(f, gw, ngw, lane); }
    if constexpr (WHICH == 5) { FU f{&p}; gemm64<false>(f, gw, ngw, lane); }
    if constexpr (WHICH == 6) { FG f{&p}; gemm64<false>(f, gw, ngw, lane); }
}

__global__ void __launch_bounds__(512) k_qkrope(P p) {
    const int lane = threadIdx.x & 63, gw = blockIdx.x * 8 + (threadIdx.x >> 6), ngw = gridDim.x * 8;
    for (int t = gw; t < T; t += ngw) {
        const int pos = t % SEQ;
        const int fi = lane & 7;
        float inv = p.inv_freq[0];
#pragma unroll
        for (int q = 1; q < 8; ++q) inv = (fi == q) ? p.inv_freq[q] : inv;
        const float ang = (float)pos * inv; const float cs = cosf(ang), sn = sinf(ang);
#pragma unroll 1
        for (int qk = 0; qk < 2; ++qk) {
            const float gn = (qk ? p.k_norm : p.q_norm)[lane];
#pragma unroll 1
            for (int h = 0; h < NH; ++h) {
                float* ptr = p.z + (size_t)t * NZ + qk * 512 + h * 64;
                float v = ptr[lane];
                const float ss = wave_sum(v * v);
                v = v * (1.0f / sqrtf(ss * (1.0f / 64.f) + EPS)) * gn;
                const float partner = __shfl_xor(v, 8);
                if (lane < 16) v = (lane < 8) ? v * cs - partner * sn : v * cs + partner * sn;
                if (qk == 0) v *= 0.125f;
                ptr[lane] = v;
            }
        }
    }
}
__global__ void __launch_bounds__(512) k_attn(P p) {
    const int lane = threadIdx.x & 63, gw = blockIdx.x * 8 + (threadIdx.x >> 6), ngw = gridDim.x * 8;
    for (int it = gw; it < T * NH; it += ngw) {
        const int t = it / NH, h = it % NH, pos = t % SEQ; const size_t tb = (size_t)(t - pos);
        const float q = p.z[(size_t)t * NZ + h * 64 + lane];
        float m = -INFINITY, l = 0.f, acc = 0.f;
#pragma unroll 1
        for (int br = 0; br < 3; ++br) {
            const int d = br == 0 ? 1 : (br == 1 ? 4 : 16);
#pragma unroll 1
            for (int j = 0; j <= 128; ++j) {
                const int tk = pos - j * d; if (tk < 0) break;
                const float* row = p.z + (tb + tk) * NZ + h * 64 + lane;
                const float s = wave_sum(q * row[512]);
                const float vv = row[1024];
                const float mn = fmaxf(m, s); const float sc = expf(m - mn), pp = expf(s - mn);
                l = l * sc + pp; acc = acc * sc + pp * vv; m = mn;
            }
        }
        const float o = acc / l;
        const float ss = wave_sum(o * o);
        p.mix[(size_t)t * DM + h * 64 + lane] = o * (1.0f / sqrtf(ss * (1.0f / 64.f) + EPS)) * p.g_attn_out[h * 64 + lane];
    }
}
__global__ void __launch_bounds__(512) k_conv(P p) {
    const int lane = threadIdx.x & 63, gw = blockIdx.x * 8 + (threadIdx.x >> 6), ngw = gridDim.x * 8;
    for (int it = gw; it < T * 8; it += ngw) {
        const int t = it / 8, g = it % 8, pos = t % SEQ, ch = g * 64 + lane;
        const float* zr = p.z + (size_t)t * NZ;
        float y = 0.f;
#pragma unroll
        for (int j = 0; j < 3; ++j) { const int back = 2 - j; if (pos - back >= 0) { const float* zz = zr - (size_t)back * NZ; y += p.conv_w[j * 512 + ch] * (zz[2048 + ch] * zz[2560 + ch]); } }
        y *= zr[1536 + ch];
        const float ss = wave_sum(y * y);
        p.mix[(size_t)t * DM + 512 + ch] = y * (1.0f / sqrtf(ss * (1.0f / 64.f) + EPS)) * p.g_conv_out[ch];
    }
}
__global__ void __launch_bounds__(512) k_route(P p) {
    const int lane = threadIdx.x & 63, gw = blockIdx.x * 8 + (threadIdx.x >> 6), ngw = gridDim.x * 8;
    for (int t = gw; t < T; t += ngw) {
        const f32x4* s = (const f32x4*)(p.h1 + (size_t)t * DM); f32x4 v[4]; float ss = 0.f;
#pragma unroll
        for (int j = 0; j < 4; ++j) { v[j] = s[lane + 64 * j]; ss += v[j].x * v[j].x + v[j].y * v[j].y + v[j].z * v[j].z + v[j].w * v[j].w; }
        ss = wave_sum(ss);
        const float r = 1.0f / sqrtf(ss * (1.0f / 1024.f) + EPS);
        float lg[4], le[16];
#pragma unroll
        for (int e = 0; e < 4; ++e) lg[e] = 0.f;
#pragma unroll
        for (int e = 0; e < 16; ++e) le[e] = 0.f;
#pragma unroll
        for (int j = 0; j < 4; ++j) {
            const f32x4 g = ((const f32x4*)p.g_ffn)[lane + 64 * j]; v[j] = v[j] * r * g;
            ((f32x4*)(p.xf + (size_t)t * DM))[lane + 64 * j] = v[j];
#pragma unroll
            for (int c = 0; c < 4; ++c) {
                const int col = 4 * (lane + 64 * j) + c; const float xv = v[j][c];
                const f32x4 wg = *(const f32x4*)(p.w_rg + (size_t)col * 4);
#pragma unroll
                for (int e = 0; e < 4; ++e) lg[e] += xv * wg[e];
#pragma unroll
                for (int q = 0; q < 4; ++q) { const f32x4 we = *(const f32x4*)(p.w_re + (size_t)col * 16 + 4 * q);
#pragma unroll
                    for (int e = 0; e < 4; ++e) le[4 * q + e] += xv * we[e]; }
            }
        }
#pragma unroll
        for (int e = 0; e < 4; ++e) lg[e] = wave_sum(lg[e]) + p.b_rg[e];
#pragma unroll
        for (int e = 0; e < 16; ++e) le[e] = wave_sum(le[e]) + p.b_re[e];
        int gi = 0; float gm = lg[0];
#pragma unroll
        for (int e = 1; e < 4; ++e) if (lg[e] > gm) { gm = lg[e]; gi = e; }
        float zs = 0.f;
#pragma unroll
        for (int e = 0; e < 4; ++e) zs += expf(lg[e] - gm);
        const float pg_top = 1.0f / zs;
        float l4[4];
#pragma unroll
        for (int i = 0; i < 4; ++i) l4[i] = gi == 0 ? le[i] : (gi == 1 ? le[4 + i] : (gi == 2 ? le[8 + i] : le[12 + i]));
        int i1 = 0; float m1 = l4[0];
#pragma unroll
        for (int i = 1; i < 4; ++i) if (l4[i] > m1) { m1 = l4[i]; i1 = i; }
        int i2 = -1; float m2 = -INFINITY;
#pragma unroll
        for (int i = 0; i < 4; ++i) if (i != i1 && l4[i] > m2) { m2 = l4[i]; i2 = i; }
        const float t1 = 1.0f / (1.0f + expf(m2 - m1)), t2 = 1.0f - t1;
        const int a = i1 < i2 ? i1 : i2, b = i1 < i2 ? i2 : i1;
        const float ga = pg_top * (a == i1 ? t1 : t2), gb = pg_top * (b == i1 ? t1 : t2);
        const int pi = a == 0 ? b - 1 : (a == 1 ? b + 1 : 5);
        const int bucket = gi * 6 + pi;
        if (lane == 0) { const int pos = atomicAdd(&p.cnt[bucket], 1); p.list[(size_t)bucket * T + pos] = t; p.tok_ga[t] = ga; p.tok_gb[t] = gb; }
    }
}
__global__ void __launch_bounds__(256) k_sorted(P p) {
    const int gid = blockIdx.x * 256 + threadIdx.x, n = gridDim.x * 256;
    for (int sr = gid; sr < MAXSR; sr += n) {
        int b, base, total; bucket_of(p.cnt, sr, b, base, total);
        int tok = -1; float ga = 0.f, gb = 0.f;
        if (b >= 0) { const int pos = sr - base; if (pos < p.cnt[b]) { tok = p.list[(size_t)b * T + pos]; ga = p.tok_ga[tok]; gb = p.tok_gb[tok]; } }
        p.srow_tok[sr] = tok; p.srow_ga[sr] = ga; p.srow_gb[sr] = gb;
    }
}

extern "C" void kernel_launch(void* const* d_in, const int* in_sizes, int n_in, void* d_out, int out_size, void* d_ws, size_t ws_size, hipStream_t stream) {
    P p{};
    const float* const* in = (const float* const*)d_in;
    if (ws_size < 512 * MiB) { hipMemsetAsync(d_out, 0xFF, (size_t)out_size * 4, stream); return; }
    for (int i = 0; i < n_in; ++i) if (((uintptr_t)d_in[i]) & 15) { hipMemsetAsync(d_out, 0x7F, (size_t)out_size * 4, stream); return; }
    p.x = in[0]; p.p = in[1]; p.g_mix = in[2]; p.w_in = in[3]; p.q_norm = in[4]; p.k_norm = in[5]; p.conv_w = in[6]; p.g_attn_out = in[7]; p.g_conv_out = in[8];
    p.w_out = in[9]; p.g_ffn = in[10]; p.w_rg = in[11]; p.b_rg = in[12]; p.w_re = in[13]; p.b_re = in[14]; p.w1 = in[15]; p.w3 = in[16]; p.w2 = in[17];
    p.g_ple = in[18]; p.w_ple_gate = in[19]; p.w_ple_proj = in[20]; p.g_ple_post = in[21];
    p.out = (float*)d_out;
    char* ws = (char*)d_ws;
    p.xn = (float*)(ws); p.mix = p.xn; p.xf = p.xn; p.xg = p.xn;
    p.z = (float*)(ws + 128 * MiB);
    p.h1 = (float*)(ws + 128 * MiB);
    p.H = (float*)(ws + 256 * MiB);
    p.u = (float*)(ws + 256 * MiB);
    char* sm = ws + 416 * MiB;
    p.cnt = (int*)sm; p.list = (int*)(sm + 4096); p.tok_ga = (float*)(sm + 4 * MiB); p.tok_gb = (float*)(sm + 5 * MiB);
    p.srow_tok = (int*)(sm + 6 * MiB); p.srow_ga = (float*)(sm + 7 * MiB); p.srow_gb = (float*)(sm + 8 * MiB);
    for (int i = 0; i < 8; ++i) p.inv_freq[i] = (float)pow(500000.0, -(double)(2 * i) / 16.0);
    const int G = 1024;
    k_rms<<<G, 512, 0, stream>>>(p.x, p.g_mix, p.xn);
    k_gemm<1><<<G, 512, 0, stream>>>(p);
    k_qkrope<<<G, 512, 0, stream>>>(p);
    k_attn<<<G * 2, 512, 0, stream>>>(p);
    k_conv<<<G, 512, 0, stream>>>(p);
    k_gemm<2><<<G, 512, 0, stream>>>(p);
    (void)hipMemsetAsync(p.cnt, 0, 4096, stream);
    k_route<<<G, 512, 0, stream>>>(p);
    k_sorted<<<160, 256, 0, stream>>>(p);
    k_gemm<3><<<G, 512, 0, stream>>>(p);
    k_gemm<4><<<G, 512, 0, stream>>>(p);
    k_rms<<<G, 512, 0, stream>>>(p.out, p.g_ple, p.xg);
    k_gemm<5><<<G, 512, 0, stream>>>(p);
    k_rms<<<G, 512, 0, stream>>>(p.u, p.g_ple_post, p.u);
    k_gemm<6><<<G, 512, 0, stream>>>(p);
}
```

```cpp
#include <hip/hip_runtime.h>
#include <stdint.h>
#include <math.h>
#include <stdio.h>

typedef float f32x16 __attribute__((ext_vector_type(16)));
typedef float f32x4 __attribute__((ext_vector_type(4)));
typedef unsigned short bf16_t;
#define LAS __attribute__((address_space(3)))

constexpr int T = 32768, DM = 1024, SEQ = 8192, NZ = 3072, NH = 8, HD = 64, PLE = 256, FF = 512, AW = 512;
constexpr int PAD = 256;
constexpr int NBKT = 24;
constexpr int MAXTILES = (T + NBKT * 256) / 256;
constexpr float EPS = 1e-6f;
constexpr size_t MiB = 1u << 20;
constexpr int NWAVES = 8;
constexpr int LDS_BYTES = 147456;
constexpr int MISC_OFF = 131072 + 320, TT_OFF = 131072 + 1024, STASH_OFF = 135168;

constexpr size_t WS_CTL = 0, CTL_ZERO_BYTES = 1 * MiB;
constexpr int CW_BAR = 4096, CW_CNT = 1024;
constexpr size_t WS_LIST = 1 * MiB, WS_TOKGA = 4 * MiB, WS_TOKGB = WS_TOKGA + 256 * 1024, WS_RINV1 = WS_TOKGB + 256 * 1024, WS_RINVX = WS_RINV1 + 256 * 1024;
constexpr size_t WS_ROPE = 6 * MiB + 512 * 1024;
constexpr size_t WS_WRH = 7 * MiB, WS_WRL = WS_WRH + 64 * 1024;
constexpr size_t WS_SSQU = 8 * MiB, WS_SSQ2 = 10 * MiB;
constexpr size_t WS_WIN = 16 * MiB, WS_WOUT = 22 * MiB, WS_W13 = 24 * MiB, WS_W2 = 56 * MiB, WS_WG = 72 * MiB, WS_WP = 74 * MiB;
constexpr size_t WS_XN = 80 * MiB;
constexpr size_t WS_Q = 144 * MiB, WS_K = 176 * MiB, WS_V = 208 * MiB, WS_CB = 240 * MiB, WS_CC = 272 * MiB, WS_CH = 304 * MiB;
constexpr size_t WS_H2F8 = 208 * MiB;
constexpr size_t WS_H1F8 = 208 * MiB;
constexpr size_t WS_H1 = 144 * MiB;
constexpr size_t WS_U = 336 * MiB;
constexpr size_t WS_XB = 336 * MiB;
constexpr size_t WS_PB = 496 * MiB;
constexpr size_t WS_PO = 400 * MiB, WS_PL = 12 * MiB;
constexpr size_t WS_H = 400 * MiB;
constexpr size_t WS_END = 512 * MiB;

struct P {
    const float *x, *p, *g_mix, *w_in, *q_norm, *k_norm, *conv_w, *g_attn_out, *g_conv_out, *w_out, *g_ffn, *w_rg, *b_rg, *w_re, *b_re,
        *w1, *w3, *w2, *g_ple, *w_ple_gate, *w_ple_proj, *g_ple_post;
    float* out;
    unsigned char* ws;
    float inv_freq[8];
};

__device__ __forceinline__ int opaque(int x) { asm volatile("" : "+v"(x)); return x; }
__device__ __forceinline__ float bf2f(unsigned b) { return __uint_as_float(b << 16); }
__device__ __forceinline__ unsigned f2bf(float f) { unsigned u = __float_as_uint(f); return (u + 0x7fffu + ((u >> 16) & 1u)) >> 16; }
__device__ __forceinline__ void bucket_of(const unsigned* cnt, int sr, int& bsel, int& base, int& total) {
    int o = 0; bsel = -1; base = 0;
#pragma unroll
    for (int b = 0; b < NBKT; ++b) { const int n = (int)cnt[b * 64], np = (n + PAD - 1) / PAD * PAD; if (sr >= o && sr < o + np) { bsel = b; base = o; } o += np; }
    total = o;
}
__device__ __forceinline__ void bucket_experts(int b, int& ea, int& eb) {
    const int g = b / 6, pi = b % 6;
    const int a = pi < 3 ? 0 : (pi < 5 ? 1 : 2);
    const int bb = pi < 3 ? pi + 1 : (pi < 5 ? pi - 1 : 3);
    ea = g * 4 + a; eb = g * 4 + bb;
}

#define XB_TMO      128
#define XB_XCNT(j)  (256  + 64 * (j))
#define XB_XSUB(j)  (1280 + 64 * (j))
#define XB_XGEN(j)  (2304 + 64 * (j))
#define XB_TOP      3328
#define XB_TOPGEN   3392
#define XCD_BAR_WORDS 3456
#define XB_SPIN_CAP (1u << 22)
__device__ __forceinline__ unsigned xb_ld(unsigned* p)              { return __hip_atomic_load(p, __ATOMIC_RELAXED, __HIP_MEMORY_SCOPE_AGENT); }
__device__ __forceinline__ unsigned xb_add(unsigned* p, unsigned v) { return __hip_atomic_fetch_add(p, v, __ATOMIC_RELAXED, __HIP_MEMORY_SCOPE_AGENT); }
__device__ __forceinline__ unsigned xb_xcc_id() { return (unsigned)__builtin_amdgcn_s_getreg((3 << 11) | 20) & 0xFu; }
#define XB_SPIN(cond, bar) do { unsigned _sp = 0; while (cond) { __builtin_amdgcn_s_sleep(1); \
    if ((++_sp & 255u) == 0u) { if (xb_ld(&(bar)[XB_TMO])) break; if (_sp > XB_SPIN_CAP) { atomicAdd(&(bar)[XB_TMO], 1u); break; } } } } while (0)
struct XcdBarrier { unsigned* bar; unsigned x; volatile LAS unsigned* st; };
__device__ __forceinline__ XcdBarrier xcd_barrier_post(unsigned* bar, volatile LAS unsigned* st) {
    XcdBarrier b; b.bar = bar; b.x = xb_xcc_id(); b.st = st;
    if (threadIdx.x == 0) (void)xb_add(&bar[XB_XCNT(b.x)], 1u);
    return b;
}
__device__ __forceinline__ void xcd_barrier_complete(unsigned* bar, unsigned x, unsigned& nloc, unsigned& nx) {
    const unsigned G = gridDim.x * gridDim.y * gridDim.z;
    unsigned sum, cnt, mine, sp = 0u;
    for (;;) {
        sum = 0u; cnt = 0u; mine = 0u;
#pragma unroll
        for (unsigned j = 0; j < 16; ++j) { const unsigned c = xb_ld(&bar[XB_XCNT(j)]); sum += c; cnt += (c > 0u) ? 1u : 0u; mine = (j == x) ? c : mine; }
        if (sum == G) break;
        __builtin_amdgcn_s_sleep(1);
        if ((++sp & 255u) == 0u) { if (xb_ld(&bar[XB_TMO])) break; if (sp > XB_SPIN_CAP) { atomicAdd(&bar[XB_TMO], 1u); break; } }
    }
    nloc = mine > 0u ? mine : 1u; nx = cnt > 0u ? cnt : 1u;
}
__device__ __forceinline__ void xcd_barrier(const XcdBarrier& b) {
    asm volatile("s_waitcnt vmcnt(0)" ::: "memory");
    __syncthreads();
    if (threadIdx.x == 0) {
        unsigned* bar = b.bar;
        __builtin_amdgcn_s_waitcnt(0);
        unsigned nloc = b.st[0], nx = b.st[1];
        if (nloc == 0u) { xcd_barrier_complete(bar, b.x, nloc, nx); b.st[0] = nloc; b.st[1] = nx; }
        const unsigned old = xb_add(&bar[XB_XSUB(b.x)], 1u);
        const unsigned gen = old / nloc;
        if (old + 1u == (gen + 1u) * nloc) {
            __builtin_amdgcn_fence(__ATOMIC_RELEASE, "agent");
            asm volatile("s_waitcnt vmcnt(0)" ::: "memory");
            const unsigned og = xb_add(&bar[XB_TOP], 1u);
            const unsigned tg = og / nx;
            if (og + 1u == (tg + 1u) * nx) xb_add(&bar[XB_TOPGEN], 1u);
            else XB_SPIN(xb_ld(&bar[XB_TOPGEN]) == tg, bar);
            __builtin_amdgcn_fence(__ATOMIC_ACQUIRE, "agent");
            xb_add(&bar[XB_XGEN(b.x)], 1u);
            asm volatile("s_waitcnt vmcnt(0)" ::: "memory");
        } else {
            XB_SPIN(xb_ld(&bar[XB_XGEN(b.x)]) == gen, bar);
            __builtin_amdgcn_fence(__ATOMIC_ACQUIRE, "agent");
            asm volatile("s_waitcnt vmcnt(0)" ::: "memory");
        }
    }
    __syncthreads();
}

namespace pg8 {
typedef short bf16x8 __attribute__((ext_vector_type(8)));
typedef unsigned u32x4 __attribute__((ext_vector_type(4)));
typedef unsigned u32x2 __attribute__((ext_vector_type(2)));
constexpr int BM = 256, BK = 64, HALF = 128, HTB = HALF * BK * 2, STAGE_BYTES = 8 * HTB, NXCD = 8, WGM = 8;
__host__ __device__ __forceinline__ int lds_byte(int r, int c) { const int st = (r >> 4) * 2 + (c >> 5), rr = r & 15, cc = c & 31, ob = rr * 64 + cc * 2; return st * 1024 + (ob ^ (((ob >> 9) & 1) << 5)); }
__host__ __device__ __forceinline__ void stage_rc(int b, int& R, int& C) { const int st = b / 1024, sb = b % 1024, swz = sb ^ (((sb >> 9) & 1) << 5); R = (st >> 1) * 16 + swz / 64; C = (st & 1) * 32 + (swz % 64) / 2; }
struct Unit { int pm, pn, ea, eb, b, base, cnt; };
struct StaticOrder {
    int nM, nN, nwg, G, c;
    __device__ void init(int M, int N, int G_, int c_) { nM = M / BM; nN = N / BM; nwg = nM * nN; G = G_; c = c_; }
    __device__ bool next(int i, Unit& u) const {
        const long L = (long)i * G + c; if (L >= nwg) return false;
        int wgid = (int)L; { const int q = nwg / NXCD, r = nwg % NXCD, xcd = wgid % NXCD, off = wgid / NXCD; wgid = (xcd < r ? xcd * (q + 1) : r * (q + 1) + (xcd - r) * q) + off; }
        const int nig = WGM * nN, gid = wgid / nig, fm = gid * WGM, gsz = (nM - fm) < WGM ? (nM - fm) : WGM;
        u.pm = fm + ((wgid % nig) % gsz); u.pn = (wgid % nig) / gsz; u.ea = 0; u.eb = 0; u.b = 0; u.base = 0; u.cnt = 0; return true;
    }
};
typedef int v4i_t __attribute__((ext_vector_type(4))); typedef int v8i_t __attribute__((ext_vector_type(8)));
__device__ __forceinline__ v8i_t ld8(const LAS unsigned char* p0, const LAS unsigned char* p1) { const v4i_t l = *(const LAS v4i_t*)p0, h = *(const LAS v4i_t*)p1; return __builtin_shufflevector(l, h, 0, 1, 2, 3, 4, 5, 6, 7); }
__device__ __forceinline__ unsigned pk4_fp8(float a, float b, float c, float d) {
    a = __builtin_amdgcn_fmed3f(a, -448.f, 448.f); b = __builtin_amdgcn_fmed3f(b, -448.f, 448.f); c = __builtin_amdgcn_fmed3f(c, -448.f, 448.f); d = __builtin_amdgcn_fmed3f(d, -448.f, 448.f);
    unsigned w = 0; w = __builtin_amdgcn_cvt_pk_fp8_f32(a, b, w, false); w = __builtin_amdgcn_cvt_pk_fp8_f32(c, d, w, true); return w; }
constexpr float F8_SA = 8.f, F8_SW1 = 128.f, F8_SH = 32.f, F8_SW2 = 64.f, F8_SA2 = 8.f, F8_SWG = 128.f;
__device__ __forceinline__ unsigned cvt_pk_bf16(float lo, float hi) { unsigned r; asm volatile("v_cvt_pk_bf16_f32 %0, %1, %2" : "=v"(r) : "v"(lo), "v"(hi)); return r; }

template <class Epi, class Sched>
__device__ __forceinline__ void gemm_phase(LAS unsigned char* lds, LAS unsigned char* stash, const Sched& S, const Epi& E) {
    const int tid = opaque((int)threadIdx.x), wid = __builtin_amdgcn_readfirstlane(tid >> 6), lane = tid & 63, wr = wid >> 2, wc = wid & 3, fr = lane & 15, fq = lane >> 4;
    constexpr int K = Sched::K, EB = Sched::EB, nt = K * EB / 128;
    constexpr bool GA = Sched::GATHER, F8 = (EB == 1);
    static_assert((K * EB) % 256 == 0 && K * EB >= 512, "K");
    unsigned voffB[2], voffA[2];
#pragma unroll
    for (int i = 0; i < 2; ++i) { int R, C; stage_rc(tid * 16 + i * 8192, R, C); voffB[i] = (unsigned)(R * Sched::LDB * EB + C * 2); voffA[i] = (unsigned)(R * Sched::LDA * EB + C * 2); }
    constexpr size_t kstep = (size_t)(BK * 2);
    constexpr size_t hstepB = (size_t)HALF * Sched::LDB * EB, hstepA = (size_t)HALF * Sched::LDA * EB;
    const unsigned ldsw = (unsigned)wid * 1024u;
    const int aoff = F8 ? lds_byte(wr * 64 + fr, 16 * fq) : lds_byte(wr * 64 + fr, fq * 8), boff = F8 ? lds_byte(wc * 32 + fr, 16 * fq) : lds_byte(wc * 32 + fr, fq * 8);
    const int aoff1 = F8 ? lds_byte(wr * 64 + fr, 16 * fq + 8) : aoff + 1024, boff1 = F8 ? lds_byte(wc * 32 + fr, 16 * fq + 8) : boff + 1024;
#define PG8_SA(b, h) (((b) * 2 + (h)) * HTB)
#define PG8_SB(b, h) ((4 + (b) * 2 + (h)) * HTB)
#define PG8_STAGE2(bufoff, gbase, o0, o1) do { \
        __builtin_amdgcn_global_load_lds((const unsigned*)((const char*)(gbase) + (o0)), (LAS unsigned*)(lds + (bufoff) + ldsw), 16, 0, 0); \
        __builtin_amdgcn_global_load_lds((const unsigned*)((const char*)(gbase) + (o1)), (LAS unsigned*)(lds + (bufoff) + ldsw + 8192), 16, 0, 0); } while (0)
#define PG8_STAGEB(bufoff, gbase) PG8_STAGE2(bufoff, gbase, voffB[0], voffB[1])
#define PG8_STAGEA(bufoff, koff, h, NX) do { if constexpr (GA) { if (NX) PG8_STAGE2(bufoff, aB + (koff), xg[h][0], xg[h][1]); else PG8_STAGE2(bufoff, aB + (koff), voG[h][0], voG[h][1]); } \
        else PG8_STAGE2(bufoff, ((NX) ? nA : cA) + (h) * hstepA + (koff), voffA[0], voffA[1]); } while (0)
#define PG8_LDA(dst, b, h) do { if constexpr (F8) { _Pragma("unroll") for (int m = 0; m < 4; ++m) dst##8[m] = ld8(lds + PG8_SA(b, h) + aoff + m * 2048, lds + PG8_SA(b, h) + aoff1 + m * 2048); } \
        else { _Pragma("unroll") for (int m = 0; m < 4; ++m) _Pragma("unroll") for (int k = 0; k < 2; ++k) dst[m][k] = *(const LAS bf16x8*)(lds + PG8_SA(b, h) + (k ? aoff1 : aoff) + m * 2048); } } while (0)
#define PG8_LDB(dst, b, h) do { if constexpr (F8) { _Pragma("unroll") for (int n = 0; n < 2; ++n) dst##8[n] = ld8(lds + PG8_SB(b, h) + boff + n * 2048, lds + PG8_SB(b, h) + boff1 + n * 2048); } \
        else { _Pragma("unroll") for (int n = 0; n < 2; ++n) _Pragma("unroll") for (int k = 0; k < 2; ++k) dst[n][k] = *(const LAS bf16x8*)(lds + PG8_SB(b, h) + (k ? boff1 : boff) + n * 2048); } } while (0)
#define PG8_MMA(ai, bj, At, Bt) do { __builtin_amdgcn_s_setprio(1); \
        if constexpr (F8) { _Pragma("unroll") for (int m = 0; m < 4; ++m) _Pragma("unroll") for (int n = 0; n < 2; ++n) \
            asm volatile("v_mfma_scale_f32_16x16x128_f8f6f4 %0, %1, %2, %0, %3, %3 op_sel_hi:[0,0,0]" : "+v"(acc[ai][bj][m][n]) : "v"(Bt##8[n]), "v"(At##8[m]), "v"(f8one)); } \
        else { _Pragma("unroll") for (int m = 0; m < 4; ++m) _Pragma("unroll") for (int n = 0; n < 2; ++n) _Pragma("unroll") for (int k = 0; k < 2; ++k) \
            acc[ai][bj][m][n] = __builtin_amdgcn_mfma_f32_16x16x32_bf16(Bt[n][k], At[m][k], acc[ai][bj][m][n], 0, 0, 0); } \
        __builtin_amdgcn_s_setprio(0); } while (0)
#define PG8_WAIT_V(n) asm volatile("s_waitcnt vmcnt(" #n ")" ::: "memory")
#define PG8_WAIT_L(n) asm volatile("s_waitcnt lgkmcnt(" #n ")" ::: "memory")
#define PG8_BAR __builtin_amdgcn_s_barrier()
#define PG8_SCHED __builtin_amdgcn_sched_barrier(0)
    Unit cur, nxt; int ui = 0;
    if (!S.next(0, cur)) return;
    f32x4 acc[2][2][4][2];
#pragma unroll
    for (int a = 0; a < 2; ++a)
#pragma unroll
        for (int b = 0; b < 2; ++b)
#pragma unroll
            for (int m = 0; m < 4; ++m)
#pragma unroll
                for (int n = 0; n < 2; ++n) acc[a][b][m][n] = (f32x4){0.f, 0.f, 0.f, 0.f};
    const int f8one = 0x7F7F7F7F;
    bf16x8 At[4][2], B0[2][2], B1[2][2];
    v8i_t At8[4], B08[2], B18[2];
    unsigned voG[2][2] = {{0u, 0u}, {0u, 0u}}, xg[2][2] = {{0u, 0u}, {0u, 0u}};
    const char* aB = nullptr; const char* cA = nullptr; const char* nA = nullptr;
    if constexpr (GA) { aB = S.a_base(); S.a_goffs(cur, tid, voG); } else { cA = S.a_ptr(cur); }
    LAS u32x4* const mystash = (LAS u32x4*)stash + tid;
    { const char* cB0 = S.b_ptr(cur, 0); const char* cB1 = S.b_ptr(cur, 1);
      PG8_STAGEB(PG8_SB(0, 0), cB0); PG8_STAGEB(PG8_SB(0, 1), cB0 + hstepB); PG8_STAGEA(PG8_SA(0, 0), 0, 0, false); PG8_STAGEA(PG8_SA(0, 1), 0, 1, false);
      if (wr == 1) PG8_BAR;
      PG8_WAIT_V(2); PG8_BAR;
      PG8_STAGEB(PG8_SB(1, 0), cB1); PG8_STAGEA(PG8_SA(1, 0), kstep, 0, false); PG8_STAGEB(PG8_SB(1, 1), cB1 + hstepB);
      PG8_WAIT_V(6); PG8_BAR; }
    for (;;) {
        const bool has_next = S.next(ui + 1, nxt);
        Unit un; un.pm = has_next ? nxt.pm : cur.pm; un.pn = has_next ? nxt.pn : cur.pn; un.ea = has_next ? nxt.ea : cur.ea; un.eb = has_next ? nxt.eb : cur.eb; un.b = has_next ? nxt.b : cur.b; un.base = has_next ? nxt.base : cur.base; un.cnt = has_next ? nxt.cnt : cur.cnt;
        if constexpr (GA) { unsigned vn[2][2]; S.a_goffs(un, tid, vn); *mystash = (u32x4){vn[0][0], vn[0][1], vn[1][0], vn[1][1]}; }
        else nA = S.a_ptr(un);
#pragma unroll 1
        for (int t = 0; t < nt; t += 2) {
            const bool last = (t == nt - 2);
            const char* b2 = last ? S.b_ptr(un, 0) : S.b_ptr(cur, t + 2);
            const char* b3 = last ? S.b_ptr(un, 1) : S.b_ptr(cur, t + 3);
            const size_t k1 = (size_t)(t + 1) * kstep, k2 = last ? 0 : (size_t)(t + 2) * kstep, k3 = k2 + kstep;
            if constexpr (GA) { if (last) { const u32x4 q = *mystash; xg[0][0] = q.x; xg[0][1] = q.y; xg[1][0] = q.z; xg[1][1] = q.w; } }
            PG8_LDB(B0, 0, 0); PG8_LDB(B1, 0, 1); PG8_SCHED; PG8_LDA(At, 0, 0); PG8_STAGEA(PG8_SA(1, 1), k1, 1, false);
            PG8_WAIT_V(8); PG8_WAIT_L(0); PG8_BAR; PG8_MMA(0, 0, At, B0); PG8_MMA(0, 1, At, B1); PG8_BAR; PG8_SCHED;
            PG8_LDA(At, 0, 1); PG8_STAGEB(PG8_SB(0, 0), b2); PG8_STAGEB(PG8_SB(0, 1), b2 + hstepB); PG8_STAGEA(PG8_SA(0, 0), k2, 0, last);
            PG8_WAIT_V(8); PG8_WAIT_L(0); PG8_BAR; PG8_MMA(1, 0, At, B0); PG8_MMA(1, 1, At, B1); PG8_BAR; PG8_SCHED;
            PG8_LDB(B0, 1, 0); PG8_LDB(B1, 1, 1); PG8_SCHED; PG8_LDA(At, 1, 0); PG8_STAGEA(PG8_SA(0, 1), k2, 1, last);
            PG8_WAIT_V(8); PG8_WAIT_L(0); PG8_BAR; PG8_MMA(0, 0, At, B0); PG8_MMA(0, 1, At, B1); PG8_BAR; PG8_SCHED;
            PG8_LDA(At, 1, 1); PG8_STAGEB(PG8_SB(1, 0), b3); PG8_STAGEB(PG8_SB(1, 1), b3 + hstepB); PG8_STAGEA(PG8_SA(1, 0), k3, 0, last);
            PG8_WAIT_V(8); PG8_WAIT_L(0); PG8_BAR; PG8_MMA(1, 0, At, B0); PG8_MMA(1, 1, At, B1); PG8_BAR; PG8_SCHED;
        }
        if (wr == 0) PG8_BAR;
        E(acc, cur, wr, wc, fr, fq);
        if (!has_next) break;
#pragma unroll
        for (int a = 0; a < 2; ++a)
#pragma unroll
            for (int b = 0; b < 2; ++b)
#pragma unroll
                for (int m = 0; m < 4; ++m)
#pragma unroll
                    for (int n = 0; n < 2; ++n) acc[a][b][m][n] = (f32x4){0.f, 0.f, 0.f, 0.f};
        cur = nxt; ++ui;
        if constexpr (GA) { const u32x4 q = *mystash; voG[0][0] = q.x; voG[0][1] = q.y; voG[1][0] = q.z; voG[1][1] = q.w; } else cA = nA;
        if (wr == 1) PG8_BAR;
    }
    PG8_WAIT_V(0);
    PG8_BAR;
#undef PG8_SA
#undef PG8_SB
#undef PG8_STAGE2
#undef PG8_STAGEB
#undef PG8_STAGEA
#undef PG8_LDA
#undef PG8_LDB
#undef PG8_MMA
#undef PG8_WAIT_V
#undef PG8_WAIT_L
#undef PG8_BAR
#undef PG8_SCHED
}

template <int K_, int LDA_, int EB_ = 2> struct DenseSched : StaticOrder {
    static constexpr int K = K_, LDB = K_, LDA = LDA_, EB = EB_; static constexpr bool GATHER = false;
    const char* A; const char* Bt;
    __device__ __forceinline__ const char* a_ptr(const Unit& u) const { return A + (size_t)u.pm * BM * LDA_ * EB_; }
    __device__ __forceinline__ const char* b_ptr(const Unit& u, int t) const { return Bt + (size_t)u.pn * BM * K_ * EB_ + (size_t)t * 128; }
};
struct UOrder {
    static constexpr int K = PLE, LDB = PLE, LDB2 = PLE, LDA = PLE, EB = 2; static constexpr bool GATHER = false;
    const char* A; const char* Bt; int first, stride, count;
    __device__ __forceinline__ void a_ready(const Unit&, int) const {}
    __device__ __forceinline__ void done(const Unit&, int) const {}
    __device__ __forceinline__ bool alt(const Unit&) const { return false; }
    __device__ __forceinline__ bool next(int i, Unit& u) const { if (i >= count) return false; const int L = first + i * stride; u.pm = L >> 2; u.pn = L & 3; u.ea = 0; u.eb = 0; u.b = 0; u.base = 0; u.cnt = 0; return true; }
    __device__ __forceinline__ const char* a_ptr(const Unit& u) const { return A + (size_t)u.pm * BM * PLE * 2; }
    __device__ __forceinline__ const char* b_ptr(const Unit& u, int t) const { return Bt + (size_t)u.pn * BM * PLE * 2 + (size_t)t * (BK * 2); }
};
__device__ __forceinline__ void tile_info(const LAS int* tt, Unit& u) {
    const int b = __builtin_amdgcn_readfirstlane(tt[u.pm * 4]), base = __builtin_amdgcn_readfirstlane(tt[u.pm * 4 + 1]), cnt = __builtin_amdgcn_readfirstlane(tt[u.pm * 4 + 2]);
    u.b = b; u.base = base; u.cnt = cnt; bucket_experts(b, u.ea, u.eb);
}
struct Moe1Sched : StaticOrder {
    static constexpr int K = DM, LDA = DM, LDB = DM, EB = 1; static constexpr bool GATHER = true;
    const char* h1b; const char* W13; const int* list; const LAS int* tt;
    __device__ __forceinline__ bool next(int i, Unit& u) const { if (!StaticOrder::next(i, u)) return false; tile_info(tt, u); return true; }
    __device__ __forceinline__ const char* a_base() const { return h1b; }
    __device__ __forceinline__ void a_goffs(const Unit& u, int tid, unsigned (&vo)[2][2]) const {
#pragma unroll
        for (int i = 0; i < 2; ++i) { int R, C; stage_rc(tid * 16 + i * 8192, R, C);
#pragma unroll
            for (int h = 0; h < 2; ++h) { const int pos = u.pm * BM - u.base + h * HALF + R; const int tok = pos < u.cnt ? list[(size_t)u.b * T + pos] : 0; vo[h][i] = (unsigned)(tok * DM + C * 2); } }
    }
    __device__ __forceinline__ const char* b_ptr(const Unit& u, int t) const { const int e = u.pn < 4 ? u.ea : u.eb; return W13 + (size_t)e * (1024 * 1024) + (size_t)(u.pn & 3) * (BM * DM) + (size_t)t * 128; }
};
struct Moe2Sched : StaticOrder {
    static constexpr int K = 1024, LDA = 1024, LDB = FF, EB = 1; static constexpr bool GATHER = false;
    const char* H; const char* W2; const LAS int* tt;
    __device__ __forceinline__ bool next(int i, Unit& u) const { if (!StaticOrder::next(i, u)) return false; tile_info(tt, u); return true; }
    __device__ __forceinline__ const char* a_ptr(const Unit& u) const { return H + (size_t)u.pm * BM * 1024; }
    __device__ __forceinline__ const char* b_ptr(const Unit& u, int t) const { const int e = t < 4 ? u.ea : u.eb; return W2 + (size_t)e * (DM * FF) + (size_t)u.pn * (BM * FF) + (size_t)(t & 3) * 128; }
};

__device__ __forceinline__ float fast_sigmoid(float v) { return __builtin_amdgcn_rcpf(1.0f + __builtin_amdgcn_exp2f(-1.4426950408889634f * v)); }
__device__ __forceinline__ void unpack8(u32x4 v, float (&f)[8]) { f[0] = __uint_as_float(v.x << 16); f[1] = __uint_as_float(v.x & 0xffff0000u); f[2] = __uint_as_float(v.y << 16); f[3] = __uint_as_float(v.y & 0xffff0000u);
    f[4] = __uint_as_float(v.z << 16); f[5] = __uint_as_float(v.z & 0xffff0000u); f[6] = __uint_as_float(v.w << 16); f[7] = __uint_as_float(v.w & 0xffff0000u); }
struct EpiZ {
    unsigned char* ws; const float* q_norm; const float* k_norm; const float* rinvx;
    __device__ __forceinline__ void operator()(const f32x4 (&acc)[2][2][4][2], const Unit& u, int wr, int wc, int fr, int fq) const {
        const int region = u.pn >> 1, cbase = (u.pn & 1) * 256 + wc * 64 + 8 * fq;
        bf16_t* base = (bf16_t*)(ws + WS_Q + (size_t)region * (32 * MiB));
        const int row0 = u.pm * BM + wr * 64 + fr;
        float rx[2][4];
#pragma unroll
        for (int ai = 0; ai < 2; ++ai)
#pragma unroll
            for (int m = 0; m < 4; ++m) rx[ai][m] = rinvx[row0 + ai * HALF + m * 16];
        if (region < 2) {
            const float* gp = region ? k_norm : q_norm; const float qs = region ? 1.0f : 0.125f * 1.4426950408889634f;
            f32x4 g[2][2];
#pragma unroll
            for (int bj = 0; bj < 2; ++bj)
#pragma unroll
                for (int n = 0; n < 2; ++n) g[bj][n] = *(const f32x4*)(gp + 32 * bj + 8 * fq + 4 * n) * qs;
            const float* ropet = (const float*)(ws + WS_ROPE);
            f32x4 ncs0, ncs1, nsn0, nsn1;
            { const int pos = row0 & (SEQ - 1); ncs0 = *(const f32x4*)(ropet + (size_t)pos * 8); ncs1 = *(const f32x4*)(ropet + (size_t)pos * 8 + 4); nsn0 = *(const f32x4*)(ropet + 65536 + (size_t)pos * 8); nsn1 = *(const f32x4*)(ropet + 65536 + (size_t)pos * 8 + 4); }
#pragma unroll
            for (int ai = 0; ai < 2; ++ai)
#pragma unroll
                for (int m = 0; m < 4; ++m) {
                    const int r = row0 + ai * HALF + m * 16;
                    const f32x4 cs0 = ncs0, cs1 = ncs1, sn0 = nsn0, sn1 = nsn1;
                    if (ai * 4 + m < 7) { const int g1 = ai * 4 + m + 1; const int pos = (row0 + (g1 >> 2) * HALF + (g1 & 3) * 16) & (SEQ - 1);
                        ncs0 = *(const f32x4*)(ropet + (size_t)pos * 8); ncs1 = *(const f32x4*)(ropet + (size_t)pos * 8 + 4); nsn0 = *(const f32x4*)(ropet + 65536 + (size_t)pos * 8); nsn1 = *(const f32x4*)(ropet + 65536 + (size_t)pos * 8 + 4); }
                    f32x4 v[2][2]; float ss = 0.f;
#pragma unroll
                    for (int bj = 0; bj < 2; ++bj)
#pragma unroll
                        for (int n = 0; n < 2; ++n) { const f32x4 x = acc[ai][bj][m][n] * rx[ai][m]; v[bj][n] = x; ss += (x[0] * x[0] + x[1] * x[1]) + (x[2] * x[2] + x[3] * x[3]); }
                    ss += __shfl_xor(ss, 16); ss += __shfl_xor(ss, 32);
                    const float ri = 1.0f / sqrtf(ss * (1.0f / 64.f) + EPS);
#pragma unroll
                    for (int bj = 0; bj < 2; ++bj)
#pragma unroll
                        for (int n = 0; n < 2; ++n) v[bj][n] = v[bj][n] * ri * g[bj][n];
#pragma unroll
                    for (int n = 0; n < 2; ++n) {
                        const f32x4 cs = n ? cs1 : cs0, sn = n ? sn1 : sn0;
#pragma unroll
                        for (int e = 0; e < 4; ++e) {
                            const float own = v[0][n][e], partner = __shfl_xor(own, 16);
                            const float rot = fq == 0 ? own * cs[e] - partner * sn[e] : own * cs[e] + partner * sn[e];
                            v[0][n][e] = fq < 2 ? rot : own;
                        }
                    }
                    bf16_t* rowp = base + (size_t)r * AW + cbase;
#pragma unroll
                    for (int bj = 0; bj < 2; ++bj) { u32x4 w; w.x = cvt_pk_bf16(v[bj][0][0], v[bj][0][1]); w.y = cvt_pk_bf16(v[bj][0][2], v[bj][0][3]); w.z = cvt_pk_bf16(v[bj][1][0], v[bj][1][1]); w.w = cvt_pk_bf16(v[bj][1][2], v[bj][1][3]);
                        *(u32x4*)(rowp + 32 * bj) = w; }
                }
        } else if (u.pn >= 8) {
            bf16_t* ub = (bf16_t*)(ws + WS_CC) + (u.pn - 8) * 128 + wc * 32 + 8 * fq;
#pragma unroll
            for (int ai = 0; ai < 2; ++ai)
#pragma unroll
                for (int m = 0; m < 4; ++m) { const float s2 = rx[ai][m] * rx[ai][m]; const f32x4 v0 = acc[ai][0][m][0] * acc[ai][1][m][0] * s2, v1 = acc[ai][0][m][1] * acc[ai][1][m][1] * s2;
                    u32x4 w; w.x = cvt_pk_bf16(v0[0], v0[1]); w.y = cvt_pk_bf16(v0[2], v0[3]); w.z = cvt_pk_bf16(v1[0], v1[1]); w.w = cvt_pk_bf16(v1[2], v1[3]);
                    *(u32x4*)(ub + (size_t)(row0 + ai * HALF + m * 16) * AW) = w; }
        } else {
#pragma unroll
            for (int ai = 0; ai < 2; ++ai)
#pragma unroll
                for (int m = 0; m < 4; ++m) { bf16_t* rowp = base + (size_t)(row0 + ai * HALF + m * 16) * AW + cbase; const float s = rx[ai][m];
#pragma unroll
                    for (int bj = 0; bj < 2; ++bj) { const f32x4 v0 = acc[ai][bj][m][0] * s, v1 = acc[ai][bj][m][1] * s; u32x4 w; w.x = cvt_pk_bf16(v0[0], v0[1]); w.y = cvt_pk_bf16(v0[2], v0[3]); w.z = cvt_pk_bf16(v1[0], v1[1]); w.w = cvt_pk_bf16(v1[2], v1[3]);
                        *(u32x4*)(rowp + 32 * bj) = w; } }
        }
    }
};
struct EpiU {
    bf16_t* U; float* ssq;
    __device__ __forceinline__ void operator()(const f32x4 (&acc)[2][2][4][2], const Unit& u, int wr, int wc, int fr, int fq) const {
        const int row0 = u.pm * BM + wr * 64 + fr, col0 = u.pn * BM + wc * 32 + 8 * fq;
#pragma unroll
        for (int ai = 0; ai < 2; ++ai)
#pragma unroll
            for (int m = 0; m < 4; ++m) { const int r = row0 + ai * HALF + m * 16; bf16_t* rowp = U + (size_t)r * DM + col0; float ss = 0.f;
#pragma unroll
                for (int bj = 0; bj < 2; ++bj) { const f32x4 v0 = acc[ai][bj][m][0], v1 = acc[ai][bj][m][1];
                    ss += (v0[0] * v0[0] + v0[1] * v0[1]) + (v0[2] * v0[2] + v0[3] * v0[3]) + (v1[0] * v1[0] + v1[1] * v1[1]) + (v1[2] * v1[2] + v1[3] * v1[3]);
                    u32x4 w; w.x = cvt_pk_bf16(v0[0], v0[1]); w.y = cvt_pk_bf16(v0[2], v0[3]); w.z = cvt_pk_bf16(v1[0], v1[1]); w.w = cvt_pk_bf16(v1[2], v1[3]);
                    *(u32x4*)(rowp + bj * HALF) = w; }
                ss += __shfl_xor(ss, 16); ss += __shfl_xor(ss, 32);
                if (fq == 0) ssq[(size_t)r * 16 + u.pn * 4 + wc] = ss; }
    }
};

struct EpiO {
    const bf16_t* xb; bf16_t* h1b; unsigned char* h1f8;
    __device__ __forceinline__ void operator()(const f32x4 (&acc)[2][2][4][2], const Unit& u, int wr, int wc, int fr, int fq) const {
        const int row0 = u.pm * BM + wr * 64 + fr, col0 = u.pn * BM + wc * 32 + 8 * fq;
        u32x4 nx0 = *(const u32x4*)(xb + (size_t)row0 * DM + col0), nx1 = *(const u32x4*)(xb + (size_t)row0 * DM + col0 + HALF);
#pragma unroll
        for (int g = 0; g < 8; ++g) { const int ai = g >> 2, m = g & 3; const size_t off = (size_t)(row0 + ai * HALF + m * 16) * DM + col0;
            const u32x4 x0 = nx0, x1 = nx1;
            if (g < 7) { const size_t o2 = (size_t)(row0 + ((g + 1) >> 2) * HALF + ((g + 1) & 3) * 16) * DM + col0; nx0 = *(const u32x4*)(xb + o2); nx1 = *(const u32x4*)(xb + o2 + HALF); }
#pragma unroll
            for (int bj = 0; bj < 2; ++bj) { float hv[8]; unpack8(bj ? x1 : x0, hv);
#pragma unroll
                for (int n = 0; n < 2; ++n)
#pragma unroll
                    for (int e = 0; e < 4; ++e) hv[4 * n + e] += acc[ai][bj][m][n][e];
                u32x4 w; w.x = cvt_pk_bf16(hv[0], hv[1]); w.y = cvt_pk_bf16(hv[2], hv[3]); w.z = cvt_pk_bf16(hv[4], hv[5]); w.w = cvt_pk_bf16(hv[6], hv[7]); *(u32x4*)(h1b + off + bj * HALF) = w;
                u32x2 w8; w8.x = pk4_fp8(hv[0] * F8_SA, hv[1] * F8_SA, hv[2] * F8_SA, hv[3] * F8_SA); w8.y = pk4_fp8(hv[4] * F8_SA, hv[5] * F8_SA, hv[6] * F8_SA, hv[7] * F8_SA); *(u32x2*)(h1f8 + off + bj * HALF) = w8; } }
    }
};
struct EpiM1 {
    unsigned char* H; const int* list; const float* rinv1; const float* tga; const float* tgb;
    __device__ __forceinline__ void operator()(const f32x4 (&acc)[2][2][4][2], const Unit& u, int wr, int wc, int fr, int fq) const {
        const int rl0 = wr * 64 + fr, col0 = (u.pn >> 2) * 512 + (u.pn & 3) * 128 + wc * 32 + 8 * fq;
        const float* gp = (u.pn < 4) ? tga : tgb; const int pos0 = u.pm * BM - u.base; const int* lb = list + (size_t)u.b * T;
        int tok[2][4];
#pragma unroll
        for (int ai = 0; ai < 2; ++ai)
#pragma unroll
            for (int m = 0; m < 4; ++m) { const int pos = pos0 + rl0 + ai * HALF + m * 16; tok[ai][m] = pos < u.cnt ? lb[pos] : -1; }
        float riv[2][4], gtv[2][4];
#pragma unroll
        for (int ai = 0; ai < 2; ++ai)
#pragma unroll
            for (int m = 0; m < 4; ++m) { const int tk = tok[ai][m]; const int tc = tk >= 0 ? tk : 0; const float a = rinv1[tc] * (1.0f / (F8_SA * F8_SW1)), b = gp[tc] * F8_SH; riv[ai][m] = tk >= 0 ? a : 0.f; gtv[ai][m] = tk >= 0 ? b : 0.f; }
#pragma unroll
        for (int ai = 0; ai < 2; ++ai)
#pragma unroll
            for (int m = 0; m < 4; ++m) { const int sr = u.pm * BM + rl0 + ai * HALF + m * 16; const float ri = riv[ai][m], gate = gtv[ai][m];
                float o[8];
#pragma unroll
                for (int n = 0; n < 2; ++n)
#pragma unroll
                    for (int e = 0; e < 4; ++e) { const float a = acc[ai][0][m][n][e] * ri, b = acc[ai][1][m][n][e] * ri; o[4 * n + e] = gate * (a * fast_sigmoid(a)) * b; }
                u32x2 w; w.x = pk4_fp8(o[0], o[1], o[2], o[3]); w.y = pk4_fp8(o[4], o[5], o[6], o[7]);
                *(u32x2*)(H + (size_t)sr * 1024 + col0) = w; }
    }
};
struct EpiM2 {
    const bf16_t* h1b; bf16_t* h2b; float* ssq; const int* list; unsigned char* h2f8;
    __device__ __forceinline__ void operator()(const f32x4 (&acc)[2][2][4][2], const Unit& u, int wr, int wc, int fr, int fq) const {
        const int rl0 = wr * 64 + fr, col0 = u.pn * BM + wc * 32 + 8 * fq; const int pos0 = u.pm * BM - u.base; const int* lb = list + (size_t)u.b * T;
        int tok[2][4];
#pragma unroll
        for (int ai = 0; ai < 2; ++ai)
#pragma unroll
            for (int m = 0; m < 4; ++m) { const int pos = pos0 + rl0 + ai * HALF + m * 16; tok[ai][m] = pos < u.cnt ? lb[pos] : -1; }
        u32x4 n0, n1;
        { const int t0 = tok[0][0]; const size_t o0 = (size_t)(t0 >= 0 ? t0 : 0) * DM + col0; n0 = *(const u32x4*)(h1b + o0); n1 = *(const u32x4*)(h1b + o0 + HALF); }
#pragma unroll
        for (int g = 0; g < 8; ++g) { const int ai = g >> 2, m = g & 3; const int tk = tok[ai][m]; const bool ok = tk >= 0; const size_t off = (size_t)(ok ? tk : 0) * DM + col0;
                const u32x4 hb0 = n0, hb1 = n1; float ss = 0.f;
                if (g < 7) { const int t2 = tok[(g + 1) >> 2][(g + 1) & 3]; const size_t o2 = (size_t)(t2 >= 0 ? t2 : 0) * DM + col0; n0 = *(const u32x4*)(h1b + o2); n1 = *(const u32x4*)(h1b + o2 + HALF); }
#pragma unroll
                for (int bj = 0; bj < 2; ++bj) { float hv[8]; unpack8(bj ? hb1 : hb0, hv);
#pragma unroll
                    for (int n = 0; n < 2; ++n)
#pragma unroll
                        for (int e = 0; e < 4; ++e) { hv[4 * n + e] += acc[ai][bj][m][n][e] * (1.0f / (F8_SH * F8_SW2)); ss += hv[4 * n + e] * hv[4 * n + e]; }
                    u32x4 w; w.x = cvt_pk_bf16(hv[0], hv[1]); w.y = cvt_pk_bf16(hv[2], hv[3]); w.z = cvt_pk_bf16(hv[4], hv[5]); w.w = cvt_pk_bf16(hv[6], hv[7]);
                    if (ok) { *(u32x4*)(h2b + off + bj * HALF) = w;
                        u32x2 w8; w8.x = pk4_fp8(hv[0] * F8_SA2, hv[1] * F8_SA2, hv[2] * F8_SA2, hv[3] * F8_SA2); w8.y = pk4_fp8(hv[4] * F8_SA2, hv[5] * F8_SA2, hv[6] * F8_SA2, hv[7] * F8_SA2); *(u32x2*)(h2f8 + off + bj * HALF) = w8; } }
                ss += __shfl_xor(ss, 16); ss += __shfl_xor(ss, 32);
                if (ok && fq == 0) ssq[(size_t)tk * 16 + u.pn * 4 + wc] = ss; }
    }
};
struct EpiG {
    float* out; const bf16_t* h2b; const bf16_t* U; const float* ssq2; const float* ssqu; const float* gpost;
    __device__ __forceinline__ void operator()(const f32x4 (&acc)[2][2][4][2], const Unit& u, int wr, int wc, int fr, int fq) const {
        const int row0 = u.pm * BM + wr * 64 + fr, col0 = u.pn * BM + wc * 32 + 8 * fq;
        f32x4 gv[2][2];
#pragma unroll
        for (int bj = 0; bj < 2; ++bj)
#pragma unroll
            for (int n = 0; n < 2; ++n) gv[bj][n] = *(const f32x4*)(gpost + col0 + bj * HALF + 4 * n);
        float r2v[8], ruv[8];
#pragma unroll
        for (int g = 0; g < 8; ++g) { const int r = row0 + (g >> 2) * HALF + (g & 3) * 16; float s2 = 0.f, su = 0.f;
#pragma unroll
            for (int q = 0; q < 4; ++q) { const f32x4 a = *(const f32x4*)(ssq2 + (size_t)r * 16 + 4 * q), b = *(const f32x4*)(ssqu + (size_t)r * 16 + 4 * q); s2 += (a[0] + a[1]) + (a[2] + a[3]); su += (b[0] + b[1]) + (b[2] + b[3]); }
            r2v[g] = (1.0f / (F8_SA2 * F8_SWG)) / sqrtf(s2 * (1.0f / 1024.f) + EPS); ruv[g] = 1.0f / sqrtf(su * (1.0f / 1024.f) + EPS); }
        u32x4 nh0, nh1, nu0, nu1;
        { const size_t o0 = (size_t)row0 * DM + col0; nh0 = *(const u32x4*)(h2b + o0); nh1 = *(const u32x4*)(h2b + o0 + HALF); nu0 = *(const u32x4*)(U + o0); nu1 = *(const u32x4*)(U + o0 + HALF); }
#pragma unroll
        for (int g = 0; g < 8; ++g) { const int ai = g >> 2, m = g & 3; const int r = row0 + ai * HALF + m * 16; const size_t off = (size_t)r * DM + col0;
                const u32x4 hb0 = nh0, hb1 = nh1, ub0 = nu0, ub1 = nu1;
                if (g < 7) { const size_t o2 = (size_t)(row0 + ((g + 1) >> 2) * HALF + ((g + 1) & 3) * 16) * DM + col0; nh0 = *(const u32x4*)(h2b + o2); nh1 = *(const u32x4*)(h2b + o2 + HALF); nu0 = *(const u32x4*)(U + o2); nu1 = *(const u32x4*)(U + o2 + HALF); }
                const float r2 = r2v[g], ru = ruv[g];
#pragma unroll
                for (int bj = 0; bj < 2; ++bj) { float hv[8], uv[8]; unpack8(bj ? hb1 : hb0, hv); unpack8(bj ? ub1 : ub0, uv);
#pragma unroll
                    for (int n = 0; n < 2; ++n) { f32x4 res;
#pragma unroll
                        for (int e = 0; e < 4; ++e) res[e] = hv[4 * n + e] + fast_sigmoid(acc[ai][bj][m][n][e] * r2) * (uv[4 * n + e] * ru * gv[bj][n][e]);
                        *(f32x4*)(out + off + bj * HALF + 4 * n) = res; } } }
    }
};
}

template <class RowMap>
__device__ __forceinline__ void p0_transpose_item(const float* W, int ldw, bf16_t* WT, int Kdst, LAS float* scr, int k0, int n0, int lane, const float* kscale, RowMap rowmap, float f8scale = 0.f) {
    f32x4 ld[8];
#pragma unroll
    for (int i = 0; i < 8; ++i) ld[i] = *(const f32x4*)(W + (size_t)(k0 + 8 * i + (lane >> 3)) * ldw + n0 + 4 * (lane & 7));
#pragma unroll
    for (int i = 0; i < 8; ++i) { const int kk = 8 * i + (lane >> 3); const float sc = kscale ? kscale[k0 + kk] : 1.0f; LAS float* d = scr + kk * 33 + 4 * (lane & 7);
        d[0] = ld[i].x * sc; d[1] = ld[i].y * sc; d[2] = ld[i].z * sc; d[3] = ld[i].w * sc; }
    asm volatile("s_waitcnt lgkmcnt(0)" ::: "memory");
    const int c = lane & 7;
#pragma unroll
    for (int j = 0; j < 4; ++j) { const int n = (lane >> 3) + 8 * j; const LAS float* s = scr + (8 * c) * 33 + n;
        pg8::u32x4 o; o.x = f2bf(s[0 * 33]) | (f2bf(s[1 * 33]) << 16); o.y = f2bf(s[2 * 33]) | (f2bf(s[3 * 33]) << 16); o.z = f2bf(s[4 * 33]) | (f2bf(s[5 * 33]) << 16); o.w = f2bf(s[6 * 33]) | (f2bf(s[7 * 33]) << 16);
        if (f8scale == 0.f) *(pg8::u32x4*)(WT + (size_t)rowmap(n0 + n) * Kdst + k0 + 8 * c) = o;
        else { pg8::u32x2 o8; o8.x = pg8::pk4_fp8(s[0 * 33] * f8scale, s[1 * 33] * f8scale, s[2 * 33] * f8scale, s[3 * 33] * f8scale); o8.y = pg8::pk4_fp8(s[4 * 33] * f8scale, s[5 * 33] * f8scale, s[6 * 33] * f8scale, s[7 * 33] * f8scale);
            *(pg8::u32x2*)((unsigned char*)WT + (size_t)rowmap(n0 + n) * Kdst + k0 + 8 * c) = o8; } }
    asm volatile("s_waitcnt lgkmcnt(0)" ::: "memory");
}
__device__ __forceinline__ int rm_head(int lc) { const int wc = lc >> 6, d = lc & 63; return 128 * (d >> 5) + 32 * wc + 16 * ((d >> 2) & 1) + 4 * ((d >> 3) & 3) + (d & 3); }
__device__ __forceinline__ int rm_perm(int lc) { const int bj = lc >> 7, wc = (lc >> 5) & 3, j = lc & 31; return 128 * bj + 32 * wc + 16 * ((j >> 2) & 1) + 4 * ((j >> 3) & 3) + (j & 3); }
__device__ __forceinline__ void p0_weights(const P& p, LAS unsigned char* lds, int vw, int nvw, int wave, int lane, int part) {
    LAS float* scr = (LAS float*)(lds + wave * 16384);
    unsigned char* ws = p.ws;
    auto perm = [](int c) { return (c & ~255) + rm_perm(c & 255); };
    constexpr int I_IN = 16 * 96, I_OUT = 16 * 32, I_G = 16 * 32, I_P = 4 * 32, I_1 = 16 * 16 * 16, I_3 = I_1, I_2 = 16 * 8 * 32;
    constexpr int NIT = I_IN + I_OUT + I_G + I_P + I_1 + I_3 + I_2;
    constexpr int NIT0 = I_IN + I_OUT + I_G + I_P;
    const int lo = part == 0 ? 0 : (part == 1 ? I_IN : NIT0 + I_1 + I_3), hi = part == 0 ? I_IN : (part == 1 ? NIT0 + I_1 + I_3 : NIT);
    for (int it = lo + vw; it < hi; it += nvw) {
        int r = it;
        if (r < I_IN) { const int kb = r / 96, nb = r % 96; p0_transpose_item(p.w_in, NZ, (bf16_t*)(ws + WS_WIN), DM, scr, 64 * kb, 32 * nb, lane, p.g_mix, [](int c) {
            if (c < 2048) return (c & ~255) + rm_head(c & 255);
            const int is_ch = c >= 2560, j = (c - 2048) & 511;
            return 256 * (8 + (j >> 7)) + rm_perm(is_ch * 128 + (j & 127)); }); continue; } r -= I_IN;
        if (r < I_OUT) { const int kb = r / 32, nb = r % 32; p0_transpose_item(p.w_out, DM, (bf16_t*)(ws + WS_WOUT), DM, scr, 64 * kb, 32 * nb, lane, nullptr, perm); continue; } r -= I_OUT;
        if (r < I_G) { const int kb = r / 32, nb = r % 32; p0_transpose_item(p.w_ple_gate, DM, (bf16_t*)(ws + WS_WG), DM, scr, 64 * kb, 32 * nb, lane, p.g_ple, perm, pg8::F8_SWG); continue; } r -= I_G;
        if (r < I_P) { const int kb = r / 32, nb = r % 32; p0_transpose_item(p.w_ple_proj, DM, (bf16_t*)(ws + WS_WP), PLE, scr, 64 * kb, 32 * nb, lane, nullptr, perm); continue; } r -= I_P;
        if (r < I_1 + I_3) {
            const int is3 = r >= I_1; if (is3) r -= I_1;
            const int e = r / 256, kb = (r % 256) / 16, nb = r % 16;
            const float* W = (is3 ? p.w3 : p.w1) + (size_t)e * DM * FF;
            bf16_t* WT = (bf16_t*)(ws + WS_W13 + (size_t)e * 1024 * DM);
            p0_transpose_item(W, FF, WT, DM, scr, 64 * kb, 32 * nb, lane, p.g_ffn, [is3](int j) { const int q = j >> 7, jl = j & 127; return 256 * q + rm_perm(is3 * 128 + jl); }, pg8::F8_SW1);
            continue; } r -= I_1 + I_3;
        { const int e = r / 256, kb = (r % 256) / 32, nb = r % 32;
          p0_transpose_item(p.w2 + (size_t)e * FF * DM, DM, (bf16_t*)(ws + WS_W2 + (size_t)e * DM * FF), FF, scr, 64 * kb, 32 * nb, lane, nullptr, perm, pg8::F8_SW2); }
    }
}
__device__ __forceinline__ void p0_rope(const P& p, int gw, int ngw, int lane);
__device__ __forceinline__ void p0_prologue(const P& p, LAS unsigned char* lds, int gw, int ngw, int wave, int lane) {
    unsigned char* ws = p.ws;
    p0_weights(p, lds, gw, ngw, wave, lane, 0);
    p0_rope(p, gw, ngw, lane);
    { bf16_t* xb = (bf16_t*)(ws + WS_XB); float* rinvx = (float*)(ws + WS_RINVX);
      for (int r = gw; r < T; r += 4 * ngw) {
          f32x4 v[4][4]; float a[4];
#pragma unroll
          for (int q = 0; q < 4; ++q) { const f32x4* s0 = (const f32x4*)(p.x + (size_t)(r + q * ngw) * DM);
#pragma unroll
              for (int j = 0; j < 4; ++j) v[q][j] = s0[lane + 64 * j]; }
#pragma unroll
          for (int q = 0; q < 4; ++q) { a[q] = 0.f;
#pragma unroll
              for (int j = 0; j < 4; ++j) a[q] += v[q][j].x * v[q][j].x + v[q][j].y * v[q][j].y + v[q][j].z * v[q][j].z + v[q][j].w * v[q][j].w; }
#pragma unroll
          for (int o = 1; o < 64; o <<= 1) {
#pragma unroll
              for (int q = 0; q < 4; ++q) a[q] += __shfl_xor(a[q], o); }
#pragma unroll
          for (int q = 0; q < 4; ++q) { if (lane == 0) rinvx[r + q * ngw] = 1.0f / sqrtf(a[q] * (1.0f / 1024.f) + EPS);
#pragma unroll
              for (int j = 0; j < 4; ++j) { pg8::u32x2 w0; w0.x = pg8::cvt_pk_bf16(v[q][j].x, v[q][j].y); w0.y = pg8::cvt_pk_bf16(v[q][j].z, v[q][j].w); *(pg8::u32x2*)(xb + (size_t)(r + q * ngw) * DM + 4 * (lane + 64 * j)) = w0; } }
      } }
}
__device__ __forceinline__ void p0_late(const P& p, int gw, int ngw, int lane) {
    unsigned char* ws = p.ws;
    { const size_t n8 = (size_t)T * PLE / 8, stride = (size_t)ngw * 64; bf16_t* pb = (bf16_t*)(ws + WS_PB);
      for (size_t i = (size_t)gw * 64 + lane; i < n8; i += 4 * stride) {
          f32x4 a[4], b[4];
#pragma unroll
          for (int q = 0; q < 4; ++q) { a[q] = ((const f32x4*)p.p)[2 * (i + q * stride)]; b[q] = ((const f32x4*)p.p)[2 * (i + q * stride) + 1]; }
#pragma unroll
          for (int q = 0; q < 4; ++q) { pg8::u32x4 o; o.x = pg8::cvt_pk_bf16(a[q].x, a[q].y); o.y = pg8::cvt_pk_bf16(a[q].z, a[q].w); o.z = pg8::cvt_pk_bf16(b[q].x, b[q].y); o.w = pg8::cvt_pk_bf16(b[q].z, b[q].w); ((pg8::u32x4*)pb)[i + q * stride] = o; } } }
    { for (int idx = gw * 64 + lane; idx < 32 * 2 * 64; idx += ngw * 64) { const int ks = idx >> 7, ct = (idx >> 6) & 1, l = idx & 63, e = 16 * ct + (l & 15), kq = l >> 4;
          unsigned hi[8], lo[8];
#pragma unroll
          for (int j = 0; j < 8; ++j) { const int k = 32 * ks + 8 * kq + j; float w = e < 4 ? p.w_rg[k * 4 + e] : (e < 20 ? p.w_re[k * 16 + (e - 4)] : 0.f); w *= p.g_ffn[k]; hi[j] = f2bf(w); lo[j] = f2bf(w - bf2f(hi[j])); }
          pg8::u32x4 oh, ol; oh.x = hi[0] | (hi[1] << 16); oh.y = hi[2] | (hi[3] << 16); oh.z = hi[4] | (hi[5] << 16); oh.w = hi[6] | (hi[7] << 16); ol.x = lo[0] | (lo[1] << 16); ol.y = lo[2] | (lo[3] << 16); ol.z = lo[4] | (lo[5] << 16); ol.w = lo[6] | (lo[7] << 16);
          ((pg8::u32x4*)(ws + WS_WRH))[idx] = oh; ((pg8::u32x4*)(ws + WS_WRL))[idx] = ol; } }
}
__device__ __forceinline__ void p0_rope(const P& p, int gw, int ngw, int lane) {
    unsigned char* ws = p.ws;
    { float* rt = (float*)(ws + WS_ROPE);
      for (int i = gw * 64 + lane; i < SEQ * 8; i += ngw * 64) { const int pos = i >> 3, fi = i & 7; float inv = p.inv_freq[0];
#pragma unroll
          for (int q = 1; q < 8; ++q) inv = (fi == q) ? p.inv_freq[q] : inv;
          const float ang = (float)pos * inv; rt[i] = cosf(ang); rt[65536 + i] = sinf(ang); } }
}

namespace att {
typedef unsigned u32x4 __attribute__((ext_vector_type(4)));
}
namespace att {
typedef short bf16x8 __attribute__((ext_vector_type(8)));
typedef short s16x4 __attribute__((ext_vector_type(4)));
typedef unsigned u32x4 __attribute__((ext_vector_type(4)));
constexpr int VPITCH = 192, OPITCH = 144, KPITCH = 144;
__device__ __forceinline__ int crow(int r, int hi) { return (r & 3) + 8 * (r >> 2) + 4 * hi; }
__device__ __forceinline__ unsigned cvtpk(float lo, float hi) { unsigned r; asm volatile("v_cvt_pk_bf16_f32 %0, %1, %2" : "=v"(r) : "v"(lo), "v"(hi)); return r; }
typedef float f32x2_t __attribute__((ext_vector_type(2))); typedef __bf16 bf16x2_t __attribute__((ext_vector_type(2)));
__device__ __forceinline__ unsigned cvtpk_c(float lo, float hi) { f32x2_t v = {lo, hi}; bf16x2_t b = __builtin_convertvector(v, bf16x2_t); return __builtin_bit_cast(unsigned, b); }
__device__ __forceinline__ s16x4 vtr(LAS unsigned char* p) { return __builtin_bit_cast(s16x4, __builtin_amdgcn_ds_read_tr16_b64_v4i16((LAS s16x4*)p)); }

struct AttLane { int kr[4], vr0, vr1; };
template <int C>
__device__ __forceinline__ void att_compute(LAS unsigned char* buf, const AttLane& L, const bf16x8 (&qf)[4], f32x16& o0, f32x16& o1, float& lsum, float bref, int i, int hi) {
    bf16x8 kf[4]; s16x4 vl[2][4];
#pragma unroll
    for (int d0 = 0; d0 < 4; ++d0) kf[d0] = *(LAS bf16x8*)(buf + L.kr[d0]);
#pragma unroll
    for (int q = 0; q < 4; ++q) { vl[0][q] = vtr(buf + 4096 + L.vr0 + q * 1024); vl[1][q] = vtr(buf + 4096 + L.vr1 + q * 1024); }
    asm volatile("s_waitcnt lgkmcnt(0)" ::: "memory");
    f32x16 sa;
#pragma unroll
    for (int r = 0; r < 16; ++r) sa[r] = -bref;
#pragma unroll
    for (int d0 = 0; d0 < 4; ++d0) sa = __builtin_amdgcn_mfma_f32_32x32x16_bf16(kf[d0], qf[d0], sa, 0, 0, 0);
    float pv[16];
#pragma unroll
    for (int r = 0; r < 16; ++r) pv[r] = __builtin_amdgcn_exp2f(sa[r]);
    if (C == 0) {
#pragma unroll
        for (int r = 0; r < 16; ++r) pv[r] = (crow(r, hi) >= i) ? pv[r] : 0.f;
    }
    if (C == 4) {
#pragma unroll
        for (int r = 0; r < 16; ++r) pv[r] = (crow(r, hi) <= i) ? pv[r] : 0.f;
    }
    float ls = 0.f;
#pragma unroll
    for (int r = 0; r < 16; ++r) ls += pv[r];
    lsum += ls;
    u32x4 w0, w1;
    w0.x = cvtpk(pv[0], pv[1]); w0.y = cvtpk(pv[2], pv[3]); w0.z = cvtpk(pv[4], pv[5]); w0.w = cvtpk(pv[6], pv[7]);
    w1.x = cvtpk(pv[8], pv[9]); w1.y = cvtpk(pv[10], pv[11]); w1.z = cvtpk(pv[12], pv[13]); w1.w = cvtpk(pv[14], pv[15]);
    const bf16x8 pa0 = __builtin_bit_cast(bf16x8, w0), pa1 = __builtin_bit_cast(bf16x8, w1);
#define ATT_VB(dh, s2) (bf16x8){vl[dh][2 * (s2)][0], vl[dh][2 * (s2)][1], vl[dh][2 * (s2)][2], vl[dh][2 * (s2)][3], vl[dh][2 * (s2) + 1][0], vl[dh][2 * (s2) + 1][1], vl[dh][2 * (s2) + 1][2], vl[dh][2 * (s2) + 1][3]}
    o0 = __builtin_amdgcn_mfma_f32_32x32x16_bf16(ATT_VB(0, 0), pa0, o0, 0, 0, 0); o1 = __builtin_amdgcn_mfma_f32_32x32x16_bf16(ATT_VB(1, 0), pa0, o1, 0, 0, 0);
    o0 = __builtin_amdgcn_mfma_f32_32x32x16_bf16(ATT_VB(0, 1), pa1, o0, 0, 0, 0); o1 = __builtin_amdgcn_mfma_f32_32x32x16_bf16(ATT_VB(1, 1), pa1, o1, 0, 0, 0);
#undef ATT_VB
}
struct GroupInfo { int dsh, dd, pos0, h, b, s0; size_t tb; };
__device__ __forceinline__ GroupInfo att_group(int k, int blk) {
    const int x = blk & 7, m = blk >> 3; GroupInfo g; g.b = k % 3; const int bh = x + 8 * (k / 3);
    g.h = bh & 7; g.tb = (size_t)(bh >> 3) * SEQ; g.dsh = 2 * g.b; g.dd = 1 << g.dsh;
    const int gper = 32 >> g.dsh, rho = m / gper;
    g.s0 = 8 * (m % gper); g.pos0 = rho + (g.s0 << (5 + g.dsh)); return g;
}
template <int ABL>
__device__ __forceinline__ void attn_phase(const P& p, LAS unsigned char* lds, int gw, int ngw, int wave, int lane) {
    const bf16_t* Q = (const bf16_t*)(p.ws + WS_Q); const bf16_t* Kb = (const bf16_t*)(p.ws + WS_K); const bf16_t* Vb = (const bf16_t*)(p.ws + WS_V);
    LAS unsigned char* obuf = lds + 98304 + wave * 4096;
    const int i = lane & 31, hi = lane >> 5, tid = wave * 64 + lane, blk = (int)blockIdx.x;
    float bref;
    { float a = fabsf(p.q_norm[lane]), b = fabsf(p.k_norm[lane]);
#pragma unroll
      for (int o = 1; o < 64; o <<= 1) { a = fmaxf(a, __shfl_xor(a, o)); b = fmaxf(b, __shfl_xor(b, o)); }
      bref = a * b * (8.0f * 1.4426950408889634f * 1.02f) + 0.25f; }
    AttLane L;
    {
#pragma unroll
      for (int d0 = 0; d0 < 4; ++d0) L.kr[d0] = i * 128 + (((2 * d0 + hi) ^ ((i >> 1) & 7)) << 4);
      const int q_ = (lane & 15) >> 2, p_ = lane & 3, cl = 2 * ((lane >> 4) & 1) + (p_ >> 1), sw4 = ((q_ >> 1) & 1) << 2, rowb = (4 * hi + q_) * 128 + (p_ & 1) * 8;
      L.vr0 = rowb + (((0 ^ sw4) + cl) << 4); L.vr1 = rowb + (((4 ^ sw4) + cl) << 4); }
    const int skv = tid >> 8, srow = (tid >> 3) & 31, sch = tid & 7;
    const int sdst = skv * 4096 + srow * 128 + ((skv ? (sch ^ (((srow >> 1) & 1) << 2)) : (sch ^ ((srow >> 1) & 7))) << 4);
    const bf16_t* sbase = skv ? Vb : Kb;
    constexpr int NROUND = 12;
    u32x4 st[12]; bf16x8 qf[4], qn[4];
#define ATT_GLOAD(g, QD) do { \
        _Pragma("unroll") for (int j = 0; j < 12; ++j) { int pt_ = (g).pos0 + (32 * (j - 4) + srow) * (g).dd; pt_ = pt_ < 0 ? 0 : pt_; st[j] = *(const u32x4*)(sbase + ((g).tb + pt_) * AW + (g).h * 64 + sch * 8); } \
        { const bf16_t* qrow_ = Q + ((g).tb + (g).pos0 + (32 * wave + i) * (g).dd) * AW + (g).h * 64 + 8 * hi; \
          _Pragma("unroll") for (int d0 = 0; d0 < 4; ++d0) QD[d0] = *(const bf16x8*)(qrow_ + 16 * d0); } } while (0)
    GroupInfo cur = att_group(0, blk);
    ATT_GLOAD(cur, qf);
    for (int k = 0; k < NROUND; ++k) {
#pragma unroll
        for (int j = 0; j < 12; ++j) *(LAS u32x4*)(lds + j * 8192 + sdst) = st[j];
        const GroupInfo nx = att_group(k + 1 < NROUND ? k + 1 : k, blk);
        asm volatile("s_waitcnt lgkmcnt(0)" ::: "memory"); __builtin_amdgcn_s_barrier(); asm volatile("" ::: "memory");
        f32x16 o0, o1;
#pragma unroll
        for (int r = 0; r < 16; ++r) { o0[r] = 0.f; o1[r] = 0.f; }
        float lsum = 0.f;
        const int s = cur.s0 + wave, cmin = s >= 4 ? 0 : 4 - s;
        LAS unsigned char* tb0 = lds + wave * 8192;
#define ATT_GLD3(j0) do { _Pragma("unroll") for (int j = (j0); j < (j0) + 3; ++j) { int pt_ = nx.pos0 + (32 * (j - 4) + srow) * nx.dd; pt_ = pt_ < 0 ? 0 : pt_; st[j] = *(const u32x4*)(sbase + (nx.tb + pt_) * AW + nx.h * 64 + sch * 8); } \
        __builtin_amdgcn_sched_barrier(0); } while (0)
        ATT_GLD3(0);
        if (cmin <= 0) att_compute<0>(tb0, L, qf, o0, o1, lsum, bref, i, hi);
        __builtin_amdgcn_sched_barrier(0); ATT_GLD3(3);
        if (cmin <= 1) att_compute<1>(tb0 + 8192, L, qf, o0, o1, lsum, bref, i, hi);
        __builtin_amdgcn_sched_barrier(0); ATT_GLD3(6);
        if (cmin <= 2) att_compute<2>(tb0 + 2 * 8192, L, qf, o0, o1, lsum, bref, i, hi);
        __builtin_amdgcn_sched_barrier(0); ATT_GLD3(9);
        if (cmin <= 3) att_compute<3>(tb0 + 3 * 8192, L, qf, o0, o1, lsum, bref, i, hi);
        __builtin_amdgcn_sched_barrier(0);
        { const bf16_t* qrow_ = Q + (nx.tb + nx.pos0 + (32 * wave + i) * nx.dd) * AW + nx.h * 64 + 8 * hi;
#pragma unroll
          for (int d0 = 0; d0 < 4; ++d0) qn[d0] = *(const bf16x8*)(qrow_ + 16 * d0); }
        __builtin_amdgcn_sched_barrier(0);
        att_compute<4>(tb0 + 4 * 8192, L, qf, o0, o1, lsum, bref, i, hi);
#undef ATT_GLD3
        lsum += __shfl_xor(lsum, 32);
        const int qpos0 = cur.pos0 + 32 * wave * cur.dd;
        bf16_t* PO = (bf16_t*)(p.ws + WS_PO) + (size_t)cur.b * T * AW; float* PL = (float*)(p.ws + WS_PL) + (size_t)cur.b * T * NH;
#pragma unroll
        for (int q4 = 0; q4 < 4; ++q4) {
            const unsigned long long w0 = (unsigned long long)cvtpk_c(o0[4 * q4], o0[4 * q4 + 1]) | ((unsigned long long)cvtpk_c(o0[4 * q4 + 2], o0[4 * q4 + 3]) << 32);
            const unsigned long long w1 = (unsigned long long)cvtpk_c(o1[4 * q4], o1[4 * q4 + 1]) | ((unsigned long long)cvtpk_c(o1[4 * q4 + 2], o1[4 * q4 + 3]) << 32);
            LAS unsigned char* a = obuf + i * 128 + 8 * hi;
            *(LAS unsigned long long*)(a + ((q4 ^ (i & 7)) << 4)) = w0; *(LAS unsigned long long*)(a + (((4 + q4) ^ (i & 7)) << 4)) = w1; }
        asm volatile("s_waitcnt lgkmcnt(0)" ::: "memory");
#pragma unroll
        for (int it = 0; it < 4; ++it) { const int row = it * 8 + (lane >> 3); const u32x4 v = *(LAS u32x4*)(obuf + row * 128 + (lane & 7) * 16); const int lc = (lane & 7) ^ (row & 7);
            *(u32x4*)(PO + (cur.tb + qpos0 + row * cur.dd) * AW + cur.h * 64 + lc * 8) = v; }
        if (hi == 0) PL[(cur.tb + qpos0 + i * cur.dd) * NH + cur.h] = lsum;
        asm volatile("s_waitcnt lgkmcnt(0)" ::: "memory"); __builtin_amdgcn_s_barrier(); asm volatile("" ::: "memory");
        cur = nx;
#pragma unroll
        for (int d0 = 0; d0 < 4; ++d0) qf[d0] = qn[d0];
    }
#undef ATT_GLOAD
}
__device__ __forceinline__ void mix_phase(const P& p, int gw, int ngw, int lane) {
    const bf16_t* PO = (const bf16_t*)(p.ws + WS_PO); const float* PL = (const float*)(p.ws + WS_PL);
    const bf16_t* CB = (const bf16_t*)(p.ws + WS_CB); const bf16_t* CC = (const bf16_t*)(p.ws + WS_CC); const bf16_t* CH = (const bf16_t*)(p.ws + WS_CH);
    bf16_t* mix = (bf16_t*)(p.ws + WS_XN);
    const int c0 = 8 * lane, hd = lane >> 3;
    float ga[8], gc[8], w0[8], w1[8], w2[8];
#pragma unroll
    for (int e = 0; e < 8; ++e) { ga[e] = p.g_attn_out[c0 + e]; gc[e] = p.g_conv_out[c0 + e]; w0[e] = p.conv_w[c0 + e]; w1[e] = p.conv_w[512 + c0 + e]; w2[e] = p.conv_w[1024 + c0 + e]; }
    auto unpack = [](u32x4 v, float (&f)[8]) { f[0] = __uint_as_float(v.x << 16); f[1] = __uint_as_float(v.x & 0xffff0000u); f[2] = __uint_as_float(v.y << 16); f[3] = __uint_as_float(v.y & 0xffff0000u);
        f[4] = __uint_as_float(v.z << 16); f[5] = __uint_as_float(v.z & 0xffff0000u); f[6] = __uint_as_float(v.w << 16); f[7] = __uint_as_float(v.w & 0xffff0000u); };
    const u32x4 z4 = {0u, 0u, 0u, 0u};
    for (int chunk = gw; chunk < T / 16; chunk += ngw) {
        for (int t = chunk * 16; t < chunk * 16 + 16; t += 2) {
            const int pos = t & (SEQ - 1);
            u32x4 po[2][3]; float pl[2][3];
#pragma unroll
            for (int k = 0; k < 2; ++k)
#pragma unroll
                for (int br = 0; br < 3; ++br) { po[k][br] = *(const u32x4*)(PO + (size_t)br * T * AW + (size_t)(t + k) * AW + c0); pl[k][br] = PL[(size_t)br * T * NH + (size_t)(t + k) * NH + hd]; }
            u32x4 cc[4], cb[2];
#pragma unroll
            for (int j = 0; j < 4; ++j) { const bool ok = (pos + j - 2) >= 0; const size_t o = (size_t)(ok ? t + j - 2 : t) * AW + c0; cc[j] = *(const u32x4*)(CC + o); if (!ok) cc[j] = z4; }
            cb[0] = *(const u32x4*)(CB + (size_t)t * AW + c0); cb[1] = *(const u32x4*)(CB + (size_t)(t + 1) * AW + c0);
            float u[4][8];
#pragma unroll
            for (int j = 0; j < 4; ++j) unpack(cc[j], u[j]);
#pragma unroll
            for (int k = 0; k < 2; ++k) {
                float o[8], f[8];
                unpack(po[k][0], o); unpack(po[k][1], f);
#pragma unroll
                for (int e = 0; e < 8; ++e) o[e] += f[e];
                unpack(po[k][2], f);
#pragma unroll
                for (int e = 0; e < 8; ++e) o[e] += f[e];
                const float il = 1.0f / (pl[k][0] + pl[k][1] + pl[k][2]); float ss = 0.f;
#pragma unroll
                for (int e = 0; e < 8; ++e) { o[e] *= il; ss += o[e] * o[e]; }
                ss += __shfl_xor(ss, 1); ss += __shfl_xor(ss, 2); ss += __shfl_xor(ss, 4);
                float ri = 1.0f / sqrtf(ss * (1.0f / 64.f) + EPS);
                u32x4 w; w.x = cvtpk(o[0] * ri * ga[0], o[1] * ri * ga[1]); w.y = cvtpk(o[2] * ri * ga[2], o[3] * ri * ga[3]); w.z = cvtpk(o[4] * ri * ga[4], o[5] * ri * ga[5]); w.w = cvtpk(o[6] * ri * ga[6], o[7] * ri * ga[7]);
                *(u32x4*)(mix + (size_t)(t + k) * DM + c0) = w;
                float y[8], a[8];
                unpack(cb[k], a); ss = 0.f;
#pragma unroll
                for (int e = 0; e < 8; ++e) { y[e] = a[e] * (w0[e] * u[k][e] + w1[e] * u[k + 1][e] + w2[e] * u[k + 2][e]); ss += y[e] * y[e]; }
                ss += __shfl_xor(ss, 1); ss += __shfl_xor(ss, 2); ss += __shfl_xor(ss, 4);
                ri = 1.0f / sqrtf(ss * (1.0f / 64.f) + EPS);
                w.x = cvtpk(y[0] * ri * gc[0], y[1] * ri * gc[1]); w.y = cvtpk(y[2] * ri * gc[2], y[3] * ri * gc[3]); w.z = cvtpk(y[4] * ri * gc[4], y[5] * ri * gc[5]); w.w = cvtpk(y[6] * ri * gc[6], y[7] * ri * gc[7]);
                *(u32x4*)(mix + (size_t)(t + k) * DM + 512 + c0) = w;
            }
        }
    }
}
}

__device__ __forceinline__ void route_phase(const P& p, LAS unsigned char* lds, int gw, int ngw, int wave, int lane, unsigned* cnt, int* list) {
    typedef short bf16x8 __attribute__((ext_vector_type(8)));
    const bf16_t* h1b = (const bf16_t*)(p.ws + WS_H1);
    const bf16x8* WH = (const bf16x8*)(p.ws + WS_WRH); const bf16x8* WL = (const bf16x8*)(p.ws + WS_WRL);
    float* tok_ga = (float*)(p.ws + WS_TOKGA); float* tok_gb = (float*)(p.ws + WS_TOKGB); float* rinv1 = (float*)(p.ws + WS_RINV1);
    LAS float* sc = (LAS float*)(lds + wave * 4096);
    const int row = lane & 15, kq = lane >> 4;
    for (int tile = gw; tile < T / 16; tile += ngw) {
        const bf16_t* arow = h1b + (size_t)(tile * 16 + row) * DM + 8 * kq;
        f32x4 a0 = {0.f, 0.f, 0.f, 0.f}, a1 = {0.f, 0.f, 0.f, 0.f}; float ss = 0.f;
#pragma unroll 4
        for (int ks = 0; ks < 32; ++ks) {
            const bf16x8 a = *(const bf16x8*)(arow + 32 * ks);
            const bf16x8 bh0 = WH[(ks * 2 + 0) * 64 + lane], bh1 = WH[(ks * 2 + 1) * 64 + lane], bl0 = WL[(ks * 2 + 0) * 64 + lane], bl1 = WL[(ks * 2 + 1) * 64 + lane];
#pragma unroll
            for (int j = 0; j < 8; ++j) { const float v = bf2f((unsigned short)a[j]); ss += v * v; }
            a0 = __builtin_amdgcn_mfma_f32_16x16x32_bf16(a, bh0, a0, 0, 0, 0); a0 = __builtin_amdgcn_mfma_f32_16x16x32_bf16(a, bl0, a0, 0, 0, 0);
            a1 = __builtin_amdgcn_mfma_f32_16x16x32_bf16(a, bh1, a1, 0, 0, 0); a1 = __builtin_amdgcn_mfma_f32_16x16x32_bf16(a, bl1, a1, 0, 0, 0);
        }
        ss += __shfl_xor(ss, 16); ss += __shfl_xor(ss, 32);
        const float r = 1.0f / sqrtf(ss * (1.0f / 1024.f) + EPS);
#pragma unroll
        for (int q = 0; q < 4; ++q) { sc[(4 * kq + q) * 33 + row] = a0[q]; sc[(4 * kq + q) * 33 + 16 + row] = a1[q]; }
        asm volatile("s_waitcnt lgkmcnt(0)" ::: "memory");
        float lg[4], le[16];
#pragma unroll
        for (int e = 0; e < 4; ++e) lg[e] = sc[row * 33 + e] * r + p.b_rg[e];
#pragma unroll
        for (int e = 0; e < 16; ++e) le[e] = sc[row * 33 + 4 + e] * r + p.b_re[e];
        asm volatile("s_waitcnt lgkmcnt(0)" ::: "memory");
        int gi = 0; float gm = lg[0];
#pragma unroll
        for (int e = 1; e < 4; ++e) if (lg[e] > gm) { gm = lg[e]; gi = e; }
        float zs = 0.f;
#pragma unroll
        for (int e = 0; e < 4; ++e) zs += expf(lg[e] - gm);
        const float pg_top = 1.0f / zs;
        float l4[4];
#pragma unroll
        for (int i = 0; i < 4; ++i) l4[i] = gi == 0 ? le[i] : (gi == 1 ? le[4 + i] : (gi == 2 ? le[8 + i] : le[12 + i]));
        int i1 = 0; float m1 = l4[0];
#pragma unroll
        for (int i = 1; i < 4; ++i) if (l4[i] > m1) { m1 = l4[i]; i1 = i; }
        int i2 = -1; float m2 = -INFINITY;
#pragma unroll
        for (int i = 0; i < 4; ++i) if (i != i1 && l4[i] > m2) { m2 = l4[i]; i2 = i; }
        if (i2 < 0) i2 = (i1 + 1) & 3;
        const float t1 = 1.0f / (1.0f + expf(m2 - m1)), t2 = 1.0f - t1;
        const int a = i1 < i2 ? i1 : i2, b = i1 < i2 ? i2 : i1;
        const float ga = pg_top * (a == i1 ? t1 : t2), gb = pg_top * (b == i1 ? t1 : t2);
        const int pi = a == 0 ? b - 1 : (a == 1 ? b + 1 : 5);
        const int bucket = gi * 6 + pi;
        LAS unsigned* lcnt = (LAS unsigned*)(lds + 65536); LAS unsigned* gbase = lcnt + 32;
        if (threadIdx.x < 32) lcnt[threadIdx.x] = 0u;
        __syncthreads();
        unsigned lrank = 0u;
        if (lane < 16) lrank = __hip_atomic_fetch_add(lcnt + bucket, 1u, __ATOMIC_RELAXED, __HIP_MEMORY_SCOPE_WORKGROUP);
        __syncthreads();
        if (threadIdx.x < NBKT) { const unsigned n = lcnt[threadIdx.x]; gbase[threadIdx.x] = n ? atomicAdd(&cnt[threadIdx.x * 64], n) : 0u; }
        __syncthreads();
        if (lane < 16) { const int t = tile * 16 + row; const int pos = (int)(gbase[bucket] + lrank); list[(size_t)bucket * T + pos] = t; tok_ga[t] = ga; tok_gb[t] = gb; rinv1[t] = r; }
        __syncthreads();
    }
}

__global__ void __launch_bounds__(NWAVES * 64, 2) mk_fwd(P p) {
    extern __shared__ __attribute__((aligned(16))) unsigned char lds[];
    const int tid = threadIdx.x, wave = __builtin_amdgcn_readfirstlane(tid >> 6);
#define lane (opaque(tid) & 63)
    const int G = gridDim.x, gw = blockIdx.x * NWAVES + wave, ngw = G * NWAVES;
    volatile LAS unsigned* MISC = (volatile LAS unsigned*)((LAS unsigned char*)lds + MISC_OFF);
    for (int u = tid; u < 32; u += NWAVES * 64) MISC[u] = 0u;
    __syncthreads();
    XcdBarrier bar = xcd_barrier_post((unsigned*)(p.ws + WS_CTL) + CW_BAR, MISC + 8);
#define GRID_BAR() xcd_barrier(bar)
    LAS unsigned char* L = (LAS unsigned char*)lds;
#ifndef PROBE_DUP
#define PROBE_DUP 0
#endif
#define REP(k) for (int rep_ = 0; rep_ < ((PROBE_DUP == (k)) ? 3 : 1); ++rep_)
    REP(1) { p0_prologue(p, L, gw, ngw, wave, lane);
    GRID_BAR(); }
    REP(2) { { pg8::DenseSched<DM, DM> S; S.init(T, NZ, G, (int)blockIdx.x); S.A = (const char*)(p.ws + WS_XB); S.Bt = (const char*)(p.ws + WS_WIN);
      pg8::EpiZ E{p.ws, p.q_norm, p.k_norm, (const float*)(p.ws + WS_RINVX)};
      pg8::gemm_phase(L, L + STASH_OFF, S, E); }
    GRID_BAR(); }
    REP(3) { att::attn_phase<0>(p, L, gw, ngw, wave, lane);
      p0_weights(p, L, gw, ngw, wave, lane, 1); p0_weights(p, L, gw, ngw, wave, lane, 2); p0_late(p, gw, ngw, lane);
    GRID_BAR(); }
    REP(4) { att::mix_phase(p, gw, ngw, lane);
    GRID_BAR(); }
    REP(5) { { pg8::DenseSched<DM, DM> S; S.init(T, DM, G, (int)blockIdx.x); S.A = (const char*)(p.ws + WS_XN); S.Bt = (const char*)(p.ws + WS_WOUT);
      pg8::EpiO E{(const bf16_t*)(p.ws + WS_XB), (bf16_t*)(p.ws + WS_H1), p.ws + WS_H1F8};
      pg8::gemm_phase(L, L + STASH_OFF, S, E); }
    GRID_BAR(); }
    REP(6) { const bool real = (rep_ == ((PROBE_DUP == 6) ? 2 : 0));
      route_phase(p, L, gw, ngw, wave, lane, (unsigned*)(p.ws + WS_CTL) + (real ? CW_CNT : 16384 + 2048 * rep_), real ? (int*)(p.ws + WS_LIST) : (int*)(p.ws + WS_PO));
    GRID_BAR(); }
    int total_sr;
    { const unsigned* cnt = (const unsigned*)(p.ws + WS_CTL) + CW_CNT; LAS int* tt = (LAS int*)(L + TT_OFF);
      int b_, base_; bucket_of(cnt, tid < MAXTILES ? tid * 256 : -1, b_, base_, total_sr);
      if (tid < MAXTILES) { if (b_ < 0) { b_ = 0; base_ = 0; } tt[tid * 4] = b_; tt[tid * 4 + 1] = base_; tt[tid * 4 + 2] = (int)cnt[b_ * 64]; tt[tid * 4 + 3] = 0; }
      __syncthreads(); }
    REP(8) { { pg8::Moe1Sched S; S.init(total_sr, 2048, G, (int)blockIdx.x); S.h1b = (const char*)(p.ws + WS_H1F8); S.W13 = (const char*)(p.ws + WS_W13); S.list = (const int*)(p.ws + WS_LIST); S.tt = (const LAS int*)(L + TT_OFF);
      pg8::EpiM1 E{p.ws + WS_H, (const int*)(p.ws + WS_LIST), (const float*)(p.ws + WS_RINV1), (const float*)(p.ws + WS_TOKGA), (const float*)(p.ws + WS_TOKGB)};
      pg8::gemm_phase(L, L + STASH_OFF, S, E); }
      { const int n1 = (total_sr / 256) * 8, r1 = n1 % G, ne1 = G - r1, c = (int)blockIdx.x; int u1 = 2 * ne1; if (u1 > 512) u1 = 512;
        pg8::UOrder S; S.A = (const char*)(p.ws + WS_PB); S.Bt = (const char*)(p.ws + WS_WP); S.first = c - r1; S.stride = ne1; S.count = (c >= r1) ? ((c - r1 + ne1 < u1) ? 2 : ((c - r1 < u1) ? 1 : 0)) : 0;
        pg8::EpiU E{(bf16_t*)(p.ws + WS_U), (float*)(p.ws + WS_SSQU)};
        pg8::gemm_phase(L, L + STASH_OFF, S, E); }
    GRID_BAR(); }
    REP(9) { { pg8::Moe2Sched S; S.init(total_sr, DM, G, (int)blockIdx.x); S.H = (const char*)(p.ws + WS_H); S.W2 = (const char*)(p.ws + WS_W2); S.tt = (const LAS int*)(L + TT_OFF);
      pg8::EpiM2 E{(const bf16_t*)(p.ws + WS_H1), (bf16_t*)(p.ws + WS_XN), (float*)(p.ws + WS_SSQ2), (const int*)(p.ws + WS_LIST), p.ws + WS_H2F8};
      pg8::gemm_phase(L, L + STASH_OFF, S, E); }
      { const int nt_ = total_sr / 256, n1 = nt_ * 8, r1 = n1 % G, ne1 = G - r1; int u1 = 2 * ne1; if (u1 > 512) u1 = 512;
        const int n2 = nt_ * 4, r2 = n2 % G, ne2 = G - r2, c = (int)blockIdx.x, rem = 512 - u1;
        pg8::UOrder S; S.A = (const char*)(p.ws + WS_PB); S.Bt = (const char*)(p.ws + WS_WP); S.first = u1 + (c - r2); S.stride = ne2; S.count = (c >= r2 && c - r2 < rem) ? (rem - (c - r2) + ne2 - 1) / ne2 : 0;
        pg8::EpiU E{(bf16_t*)(p.ws + WS_U), (float*)(p.ws + WS_SSQU)};
        pg8::gemm_phase(L, L + STASH_OFF, S, E); }
    GRID_BAR(); }
    REP(10) { { pg8::DenseSched<DM, DM, 1> S; S.init(T, DM, G, (int)blockIdx.x); S.A = (const char*)(p.ws + WS_H2F8); S.Bt = (const char*)(p.ws + WS_WG);
      pg8::EpiG E{p.out, (const bf16_t*)(p.ws + WS_XN), (const bf16_t*)(p.ws + WS_U), (const float*)(p.ws + WS_SSQ2), (const float*)(p.ws + WS_SSQU), p.g_ple_post};
      pg8::gemm_phase(L, L + STASH_OFF, S, E); }
      if (rep_ + 1 < ((PROBE_DUP == 10) ? 3 : 1)) GRID_BAR(); }
}

extern "C" void kernel_launch(void* const* d_in, const int* in_sizes, int n_in, void* d_out, int out_size, void* d_ws, size_t ws_size, hipStream_t stream) {
    static int grid = 0;
    if (grid == 0) {
        int dev = 0, cus = 0, per_cu = 0;
        if (n_in != 22 || out_size != T * DM || ws_size < WS_END) { fprintf(stderr, "kernel_launch: unexpected problem shape / workspace\n"); grid = -1; return; }
        (void)hipGetDevice(&dev);
        (void)hipDeviceGetAttribute(&cus, hipDeviceAttributeMultiprocessorCount, dev);
        (void)hipFuncSetAttribute((const void*)mk_fwd, hipFuncAttributeMaxDynamicSharedMemorySize, LDS_BYTES);
        (void)hipOccupancyMaxActiveBlocksPerMultiprocessor(&per_cu, (const void*)mk_fwd, NWAVES * 64, LDS_BYTES);
        (void)hipGetLastError();
        if (per_cu < 1) { fprintf(stderr, "kernel_launch: occupancy query says %d blocks/CU\n", per_cu); grid = -1; return; }
        grid = cus;
    }
    if (grid < 0) return;
    P p{};
    const float* const* in = (const float* const*)d_in;
    p.x = in[0]; p.p = in[1]; p.g_mix = in[2]; p.w_in = in[3]; p.q_norm = in[4]; p.k_norm = in[5]; p.conv_w = in[6]; p.g_attn_out = in[7]; p.g_conv_out = in[8];
    p.w_out = in[9]; p.g_ffn = in[10]; p.w_rg = in[11]; p.b_rg = in[12]; p.w_re = in[13]; p.b_re = in[14]; p.w1 = in[15]; p.w3 = in[16]; p.w2 = in[17];
    p.g_ple = in[18]; p.w_ple_gate = in[19]; p.w_ple_proj = in[20]; p.g_ple_post = in[21];
    p.out = (float*)d_out; p.ws = (unsigned char*)d_ws;
    for (int i = 0; i < 8; ++i) p.inv_freq[i] = (float)pow(500000.0, -(double)(2 * i) / 16.0);
    (void)hipMemsetAsync((char*)d_ws + WS_CTL, 0, CTL_ZERO_BYTES, stream);
    void* args[] = {&p};
    hipError_t e = hipLaunchCooperativeKernel((const void*)mk_fwd, dim3(grid), dim3(NWAVES * 64), args, LDS_BYTES, stream);
    if (e != hipSuccess) fprintf(stderr, "cooperative launch failed: %s (grid %d)\n", hipGetErrorString(e), grid);
}
```

```cpp
#include <hip/hip_runtime.h>
#include <stdint.h>
#include <math.h>
#include <stdio.h>

typedef float f32x16 __attribute__((ext_vector_type(16)));
typedef float f32x4 __attribute__((ext_vector_type(4)));
typedef unsigned short bf16_t;
#define LAS __attribute__((address_space(3)))

constexpr int T = 32768, DM = 1024, SEQ = 8192, NZ = 3072, NH = 8, HD = 64, PLE = 256, FF = 512, AW = 512;
constexpr int PAD = 256;
constexpr int NBKT = 24;
constexpr int MAXTILES = (T + NBKT * 256) / 256;
constexpr float EPS = 1e-6f;
constexpr size_t MiB = 1u << 20;
constexpr int NWAVES = 8;
constexpr int LDS_BYTES = 147456;
constexpr int MISC_OFF = 131072 + 320, TT_OFF = 131072 + 1024, STASH_OFF = 135168;

constexpr size_t WS_CTL = 0, CTL_ZERO_BYTES = 1 * MiB;
constexpr int CW_BAR = 4096, CW_CNT = 1024;
constexpr size_t WS_LIST = 1 * MiB, WS_TOKGA = 4 * MiB, WS_TOKGB = WS_TOKGA + 256 * 1024, WS_RINV1 = WS_TOKGB + 256 * 1024, WS_RINVX = WS_RINV1 + 256 * 1024;
constexpr size_t WS_ROPE = 6 * MiB + 512 * 1024;
constexpr size_t WS_WRH = 7 * MiB, WS_WRL = WS_WRH + 64 * 1024;
constexpr size_t WS_SSQU = 8 * MiB, WS_SSQ2 = 10 * MiB;
constexpr size_t WS_WIN = 16 * MiB, WS_WOUT = 22 * MiB, WS_W13 = 24 * MiB, WS_W2 = 56 * MiB, WS_WG = 72 * MiB, WS_WP = 74 * MiB;
constexpr size_t WS_XN = 80 * MiB;
constexpr size_t WS_REC = 304 * MiB;
constexpr size_t WS_Q = 144 * MiB, WS_K = 176 * MiB, WS_V = 208 * MiB, WS_CB = 240 * MiB, WS_CC = 272 * MiB, WS_CH = 304 * MiB;
constexpr size_t WS_H2F8 = 208 * MiB;
constexpr size_t WS_H1F8 = 208 * MiB;
constexpr size_t WS_H1 = 144 * MiB;
constexpr size_t WS_U = 336 * MiB;
constexpr size_t WS_XB = 336 * MiB;
constexpr size_t WS_PB = 496 * MiB;
constexpr size_t WS_PO = 400 * MiB, WS_PL = 12 * MiB;
constexpr size_t WS_H = 400 * MiB;
constexpr size_t WS_END = 512 * MiB;

struct P {
    const float *x, *p, *g_mix, *w_in, *q_norm, *k_norm, *conv_w, *g_attn_out, *g_conv_out, *w_out, *g_ffn, *w_rg, *b_rg, *w_re, *b_re,
        *w1, *w3, *w2, *g_ple, *w_ple_gate, *w_ple_proj, *g_ple_post;
    float* out;
    unsigned char* ws;
    float inv_freq[8];
};

__device__ __forceinline__ int opaque(int x) { asm volatile("" : "+v"(x)); return x; }
__device__ __forceinline__ float bf2f(unsigned b) { return __uint_as_float(b << 16); }
__device__ __forceinline__ unsigned f2bf(float f) { unsigned u = __float_as_uint(f); return (u + 0x7fffu + ((u >> 16) & 1u)) >> 16; }
__device__ __forceinline__ void bucket_of(const unsigned* cnt, int sr, int& bsel, int& base, int& total) {
    int o = 0; bsel = -1; base = 0;
#pragma unroll
    for (int b = 0; b < NBKT; ++b) { const int n = (int)cnt[b * 64], np = (n + PAD - 1) / PAD * PAD; if (sr >= o && sr < o + np) { bsel = b; base = o; } o += np; }
    total = o;
}
__device__ __forceinline__ void bucket_experts(int b, int& ea, int& eb) {
    const int g = b / 6, pi = b % 6;
    const int a = pi < 3 ? 0 : (pi < 5 ? 1 : 2);
    const int bb = pi < 3 ? pi + 1 : (pi < 5 ? pi - 1 : 3);
    ea = g * 4 + a; eb = g * 4 + bb;
}

#define XB_TMO      128
#define XB_XCNT(j)  (256  + 64 * (j))
#define XB_XSUB(j)  (1280 + 64 * (j))
#define XB_XGEN(j)  (2304 + 64 * (j))
#define XB_TOP      3328
#define XB_TOPGEN   3392
#define XCD_BAR_WORDS 3456
#define XB_SPIN_CAP (1u << 22)
__device__ __forceinline__ unsigned xb_ld(unsigned* p)              { return __hip_atomic_load(p, __ATOMIC_RELAXED, __HIP_MEMORY_SCOPE_AGENT); }
__device__ __forceinline__ unsigned xb_add(unsigned* p, unsigned v) { return __hip_atomic_fetch_add(p, v, __ATOMIC_RELAXED, __HIP_MEMORY_SCOPE_AGENT); }
__device__ __forceinline__ unsigned xb_xcc_id() { return (unsigned)__builtin_amdgcn_s_getreg((3 << 11) | 20) & 0xFu; }
#define XB_SPIN(cond, bar) do { unsigned _sp = 0; while (cond) { __builtin_amdgcn_s_sleep(1); \
    if ((++_sp & 255u) == 0u) { if (xb_ld(&(bar)[XB_TMO])) break; if (_sp > XB_SPIN_CAP) { atomicAdd(&(bar)[XB_TMO], 1u); break; } } } } while (0)
struct XcdBarrier { unsigned* bar; unsigned x; volatile LAS unsigned* st; };
__device__ __forceinline__ XcdBarrier xcd_barrier_post(unsigned* bar, volatile LAS unsigned* st) {
    XcdBarrier b; b.bar = bar; b.x = xb_xcc_id(); b.st = st;
    if (threadIdx.x == 0) (void)xb_add(&bar[XB_XCNT(b.x)], 1u);
    return b;
}
__device__ __forceinline__ void xcd_barrier_complete(unsigned* bar, unsigned x, unsigned& nloc, unsigned& nx) {
    const unsigned G = gridDim.x * gridDim.y * gridDim.z;
    unsigned sum, cnt, mine, sp = 0u;
    for (;;) {
        sum = 0u; cnt = 0u; mine = 0u;
#pragma unroll
        for (unsigned j = 0; j < 16; ++j) { const unsigned c = xb_ld(&bar[XB_XCNT(j)]); sum += c; cnt += (c > 0u) ? 1u : 0u; mine = (j == x) ? c : mine; }
        if (sum == G) break;
        __builtin_amdgcn_s_sleep(1);
        if ((++sp & 255u) == 0u) { if (xb_ld(&bar[XB_TMO])) break; if (sp > XB_SPIN_CAP) { atomicAdd(&bar[XB_TMO], 1u); break; } }
    }
    nloc = mine > 0u ? mine : 1u; nx = cnt > 0u ? cnt : 1u;
}
__device__ __forceinline__ void xcd_barrier(const XcdBarrier& b) {
    asm volatile("s_waitcnt vmcnt(0)" ::: "memory");
    __syncthreads();
    if (threadIdx.x == 0) {
        unsigned* bar = b.bar;
        __builtin_amdgcn_s_waitcnt(0);
        unsigned nloc = b.st[0], nx = b.st[1];
        if (nloc == 0u) { xcd_barrier_complete(bar, b.x, nloc, nx); b.st[0] = nloc; b.st[1] = nx; }
        const unsigned old = xb_add(&bar[XB_XSUB(b.x)], 1u);
        const unsigned gen = old / nloc;
        if (old + 1u == (gen + 1u) * nloc) {
            __builtin_amdgcn_fence(__ATOMIC_RELEASE, "agent");
            asm volatile("s_waitcnt vmcnt(0)" ::: "memory");
            const unsigned og = xb_add(&bar[XB_TOP], 1u);
            const unsigned tg = og / nx;
            if (og + 1u == (tg + 1u) * nx) xb_add(&bar[XB_TOPGEN], 1u);
            else XB_SPIN(xb_ld(&bar[XB_TOPGEN]) == tg, bar);
            __builtin_amdgcn_fence(__ATOMIC_ACQUIRE, "agent");
            xb_add(&bar[XB_XGEN(b.x)], 1u);
            asm volatile("s_waitcnt vmcnt(0)" ::: "memory");
        } else {
            XB_SPIN(xb_ld(&bar[XB_XGEN(b.x)]) == gen, bar);
            __builtin_amdgcn_fence(__ATOMIC_ACQUIRE, "agent");
            asm volatile("s_waitcnt vmcnt(0)" ::: "memory");
        }
    }
    __syncthreads();
}

namespace pg8 {
typedef short bf16x8 __attribute__((ext_vector_type(8)));
typedef unsigned u32x4 __attribute__((ext_vector_type(4)));
typedef unsigned u32x2 __attribute__((ext_vector_type(2)));
constexpr int BM = 256, BK = 64, HALF = 128, HTB = HALF * BK * 2, STAGE_BYTES = 8 * HTB, NXCD = 8, WGM = 8;
__host__ __device__ __forceinline__ int lds_byte(int r, int c) { const int st = (r >> 4) * 2 + (c >> 5), rr = r & 15, cc = c & 31, ob = rr * 64 + cc * 2; return st * 1024 + (ob ^ (((ob >> 9) & 1) << 5)); }
__host__ __device__ __forceinline__ void stage_rc(int b, int& R, int& C) { const int st = b / 1024, sb = b % 1024, swz = sb ^ (((sb >> 9) & 1) << 5); R = (st >> 1) * 16 + swz / 64; C = (st & 1) * 32 + (swz % 64) / 2; }
struct Unit { int pm, pn, ea, eb, b, base, cnt; };
struct StaticOrder {
    int nM, nN, nwg, G, c, split;
    __device__ void init(int M, int N, int G_, int c_) { nM = M / BM; nN = N / BM; nwg = nM * nN; G = G_; c = c_; split = 0; }
    __device__ void tail_split() { const int s_ = (nwg / G) * G; split = (s_ > 0 && s_ < nwg && s_ % nN == 0) ? s_ : 0; }
    __device__ bool next(int i, Unit& u) const {
        const long L = (long)i * G + c; if (L >= nwg) return false;
        int wgid = (int)L; u.ea = 0; u.eb = 0; u.b = 0; u.base = 0; u.cnt = 0;
        if (split > 0 && wgid >= split) { u.pm = wgid / nN; u.pn = wgid % nN; return true; }
        const int nwge = split > 0 ? split : nwg, nMe = split > 0 ? split / nN : nM;
        { const int q = nwge / NXCD, r = nwge % NXCD, xcd = wgid % NXCD, off = wgid / NXCD; wgid = (xcd < r ? xcd * (q + 1) : r * (q + 1) + (xcd - r) * q) + off; }
        const int nig = WGM * nN, gid = wgid / nig, fm = gid * WGM, gsz = (nMe - fm) < WGM ? (nMe - fm) : WGM;
        u.pm = fm + ((wgid % nig) % gsz); u.pn = (wgid % nig) / gsz; return true;
    }
};
typedef int v4i_t __attribute__((ext_vector_type(4))); typedef int v8i_t __attribute__((ext_vector_type(8)));
__device__ __forceinline__ v8i_t ld8(const LAS unsigned char* p0, const LAS unsigned char* p1) { const v4i_t l = *(const LAS v4i_t*)p0, h = *(const LAS v4i_t*)p1; return __builtin_shufflevector(l, h, 0, 1, 2, 3, 4, 5, 6, 7); }
__device__ __forceinline__ unsigned pk4_fp8(float a, float b, float c, float d) {
    a = __builtin_amdgcn_fmed3f(a, -448.f, 448.f); b = __builtin_amdgcn_fmed3f(b, -448.f, 448.f); c = __builtin_amdgcn_fmed3f(c, -448.f, 448.f); d = __builtin_amdgcn_fmed3f(d, -448.f, 448.f);
    unsigned w = 0; w = __builtin_amdgcn_cvt_pk_fp8_f32(a, b, w, false); w = __builtin_amdgcn_cvt_pk_fp8_f32(c, d, w, true); return w; }
constexpr float F8_SA = 8.f, F8_SW1 = 128.f, F8_SH = 32.f, F8_SW2 = 64.f, F8_SA2 = 8.f, F8_SWG = 128.f;
__device__ __forceinline__ unsigned cvt_pk_bf16(float lo, float hi) { unsigned r; asm volatile("v_cvt_pk_bf16_f32 %0, %1, %2" : "=v"(r) : "v"(lo), "v"(hi)); return r; }

template <class Epi, class Sched>
__device__ __forceinline__ void gemm_phase(LAS unsigned char* lds, LAS unsigned char* stash, const Sched& S, const Epi& E) {
    const int tid = opaque((int)threadIdx.x), wid = __builtin_amdgcn_readfirstlane(tid >> 6), lane = tid & 63, wr = wid >> 2, wc = wid & 3, fr = lane & 15, fq = lane >> 4;
    constexpr int K = Sched::K, EB = Sched::EB, nt = K * EB / 128;
    constexpr bool GA = Sched::GATHER, F8 = (EB == 1);
    static_assert((K * EB) % 256 == 0 && K * EB >= 512, "K");
    unsigned voffB[2], voffA[2];
#pragma unroll
    for (int i = 0; i < 2; ++i) { int R, C; stage_rc(tid * 16 + i * 8192, R, C); voffB[i] = (unsigned)(R * Sched::LDB * EB + C * 2); voffA[i] = (unsigned)(R * Sched::LDA * EB + C * 2); }
    constexpr size_t kstep = (size_t)(BK * 2);
    constexpr size_t hstepB = (size_t)HALF * Sched::LDB * EB, hstepA = (size_t)HALF * Sched::LDA * EB;
    const unsigned ldsw = (unsigned)wid * 1024u;
    const int aoff = F8 ? lds_byte(wr * 64 + fr, 16 * fq) : lds_byte(wr * 64 + fr, fq * 8), boff = F8 ? lds_byte(wc * 32 + fr, 16 * fq) : lds_byte(wc * 32 + fr, fq * 8);
    const int aoff1 = F8 ? lds_byte(wr * 64 + fr, 16 * fq + 8) : aoff + 1024, boff1 = F8 ? lds_byte(wc * 32 + fr, 16 * fq + 8) : boff + 1024;
#define PG8_SA(b, h) (((b) * 2 + (h)) * HTB)
#define PG8_SB(b, h) ((4 + (b) * 2 + (h)) * HTB)
#define PG8_STAGE2(bufoff, gbase, o0, o1) do { \
        __builtin_amdgcn_global_load_lds((const unsigned*)((const char*)(gbase) + (o0)), (LAS unsigned*)(lds + (bufoff) + ldsw), 16, 0, 0); \
        __builtin_amdgcn_global_load_lds((const unsigned*)((const char*)(gbase) + (o1)), (LAS unsigned*)(lds + (bufoff) + ldsw + 8192), 16, 0, 0); } while (0)
#define PG8_STAGEB(bufoff, gbase) PG8_STAGE2(bufoff, gbase, voffB[0], voffB[1])
#define PG8_STAGEA(bufoff, koff, h, NX) do { if constexpr (GA) { if (NX) PG8_STAGE2(bufoff, aB + (koff), xg[h][0], xg[h][1]); else PG8_STAGE2(bufoff, aB + (koff), voG[h][0], voG[h][1]); } \
        else PG8_STAGE2(bufoff, ((NX) ? nA : cA) + (h) * hstepA + (koff), voffA[0], voffA[1]); } while (0)
#define PG8_LDA(dst, b, h) do { if constexpr (F8) { _Pragma("unroll") for (int m = 0; m < 4; ++m) dst##8[m] = ld8(lds + PG8_SA(b, h) + aoff + m * 2048, lds + PG8_SA(b, h) + aoff1 + m * 2048); } \
        else { _Pragma("unroll") for (int m = 0; m < 4; ++m) _Pragma("unroll") for (int k = 0; k < 2; ++k) dst[m][k] = *(const LAS bf16x8*)(lds + PG8_SA(b, h) + (k ? aoff1 : aoff) + m * 2048); } } while (0)
#define PG8_LDB(dst, b, h) do { if constexpr (F8) { _Pragma("unroll") for (int n = 0; n < 2; ++n) dst##8[n] = ld8(lds + PG8_SB(b, h) + boff + n * 2048, lds + PG8_SB(b, h) + boff1 + n * 2048); } \
        else { _Pragma("unroll") for (int n = 0; n < 2; ++n) _Pragma("unroll") for (int k = 0; k < 2; ++k) dst[n][k] = *(const LAS bf16x8*)(lds + PG8_SB(b, h) + (k ? boff1 : boff) + n * 2048); } } while (0)
#define PG8_MMA(ai, bj, At, Bt) do { __builtin_amdgcn_s_setprio(1); \
        if constexpr (F8) { _Pragma("unroll") for (int m = 0; m < 4; ++m) _Pragma("unroll") for (int n = 0; n < 2; ++n) \
            asm volatile("v_mfma_scale_f32_16x16x128_f8f6f4 %0, %1, %2, %0, %3, %3 op_sel_hi:[0,0,0]" : "+v"(acc[ai][bj][m][n]) : "v"(Bt##8[n]), "v"(At##8[m]), "v"(f8one)); } \
        else { _Pragma("unroll") for (int m = 0; m < 4; ++m) _Pragma("unroll") for (int n = 0; n < 2; ++n) _Pragma("unroll") for (int k = 0; k < 2; ++k) \
            acc[ai][bj][m][n] = __builtin_amdgcn_mfma_f32_16x16x32_bf16(Bt[n][k], At[m][k], acc[ai][bj][m][n], 0, 0, 0); } \
        __builtin_amdgcn_s_setprio(0); } while (0)
#define PG8_WAIT_V(n) asm volatile("s_waitcnt vmcnt(" #n ")" ::: "memory")
#define PG8_WAIT_L(n) asm volatile("s_waitcnt lgkmcnt(" #n ")" ::: "memory")
#define PG8_BAR __builtin_amdgcn_s_barrier()
#define PG8_SCHED __builtin_amdgcn_sched_barrier(0)
    Unit cur, nxt; int ui = 0;
    if (!S.next(0, cur)) return;
    f32x4 acc[2][2][4][2];
#pragma unroll
    for (int a = 0; a < 2; ++a)
#pragma unroll
        for (int b = 0; b < 2; ++b)
#pragma unroll
            for (int m = 0; m < 4; ++m)
#pragma unroll
                for (int n = 0; n < 2; ++n) acc[a][b][m][n] = (f32x4){0.f, 0.f, 0.f, 0.f};
    const int f8one = 0x7F7F7F7F;
    bf16x8 At[4][2], B0[2][2], B1[2][2];
    v8i_t At8[4], B08[2], B18[2];
    unsigned voG[2][2] = {{0u, 0u}, {0u, 0u}}, xg[2][2] = {{0u, 0u}, {0u, 0u}};
    const char* aB = nullptr; const char* cA = nullptr; const char* nA = nullptr;
    if constexpr (GA) { aB = S.a_base(); S.a_goffs(cur, tid, voG); } else { cA = S.a_ptr(cur); }
    LAS u32x4* const mystash = (LAS u32x4*)stash + tid;
    { const char* cB0 = S.b_ptr(cur, 0); const char* cB1 = S.b_ptr(cur, 1);
      PG8_STAGEB(PG8_SB(0, 0), cB0); PG8_STAGEB(PG8_SB(0, 1), cB0 + hstepB); PG8_STAGEA(PG8_SA(0, 0), 0, 0, false); PG8_STAGEA(PG8_SA(0, 1), 0, 1, false);
      if (wr == 1) PG8_BAR;
      PG8_WAIT_V(2); PG8_BAR;
      PG8_STAGEB(PG8_SB(1, 0), cB1); PG8_STAGEA(PG8_SA(1, 0), kstep, 0, false); PG8_STAGEB(PG8_SB(1, 1), cB1 + hstepB);
      PG8_WAIT_V(6); PG8_BAR; }
    for (;;) {
        const bool has_next = S.next(ui + 1, nxt);
        Unit un; un.pm = has_next ? nxt.pm : cur.pm; un.pn = has_next ? nxt.pn : cur.pn; un.ea = has_next ? nxt.ea : cur.ea; un.eb = has_next ? nxt.eb : cur.eb; un.b = has_next ? nxt.b : cur.b; un.base = has_next ? nxt.base : cur.base; un.cnt = has_next ? nxt.cnt : cur.cnt;
        if constexpr (GA) { unsigned vn[2][2]; S.a_goffs(un, tid, vn); *mystash = (u32x4){vn[0][0], vn[0][1], vn[1][0], vn[1][1]}; }
        else nA = S.a_ptr(un);
#pragma unroll 1
        for (int t = 0; t < nt; t += 2) {
            const bool last = (t == nt - 2);
            const char* b2 = last ? S.b_ptr(un, 0) : S.b_ptr(cur, t + 2);
            const char* b3 = last ? S.b_ptr(un, 1) : S.b_ptr(cur, t + 3);
            const size_t k1 = (size_t)(t + 1) * kstep, k2 = last ? 0 : (size_t)(t + 2) * kstep, k3 = k2 + kstep;
            if constexpr (GA) { if (last) { const u32x4 q = *mystash; xg[0][0] = q.x; xg[0][1] = q.y; xg[1][0] = q.z; xg[1][1] = q.w; } }
            PG8_LDB(B0, 0, 0); PG8_LDB(B1, 0, 1); PG8_SCHED; PG8_LDA(At, 0, 0); PG8_STAGEA(PG8_SA(1, 1), k1, 1, false);
            PG8_WAIT_V(8); PG8_WAIT_L(0); PG8_BAR; PG8_MMA(0, 0, At, B0); PG8_MMA(0, 1, At, B1); PG8_BAR; PG8_SCHED;
            PG8_LDA(At, 0, 1); PG8_STAGEB(PG8_SB(0, 0), b2); PG8_STAGEB(PG8_SB(0, 1), b2 + hstepB); PG8_STAGEA(PG8_SA(0, 0), k2, 0, last);
            PG8_WAIT_V(8); PG8_WAIT_L(0); PG8_BAR; PG8_MMA(1, 0, At, B0); PG8_MMA(1, 1, At, B1); PG8_BAR; PG8_SCHED;
            PG8_LDB(B0, 1, 0); PG8_LDB(B1, 1, 1); PG8_SCHED; PG8_LDA(At, 1, 0); PG8_STAGEA(PG8_SA(0, 1), k2, 1, last);
            PG8_WAIT_V(8); PG8_WAIT_L(0); PG8_BAR; PG8_MMA(0, 0, At, B0); PG8_MMA(0, 1, At, B1); PG8_BAR; PG8_SCHED;
            PG8_LDA(At, 1, 1); PG8_STAGEB(PG8_SB(1, 0), b3); PG8_STAGEB(PG8_SB(1, 1), b3 + hstepB); PG8_STAGEA(PG8_SA(1, 0), k3, 0, last);
            PG8_WAIT_V(8); PG8_WAIT_L(0); PG8_BAR; PG8_MMA(1, 0, At, B0); PG8_MMA(1, 1, At, B1); PG8_BAR; PG8_SCHED;
        }
        if (wr == 0) PG8_BAR;
        E(acc, cur, wr, wc, fr, fq);
        if (!has_next) break;
#pragma unroll
        for (int a = 0; a < 2; ++a)
#pragma unroll
            for (int b = 0; b < 2; ++b)
#pragma unroll
                for (int m = 0; m < 4; ++m)
#pragma unroll
                    for (int n = 0; n < 2; ++n) acc[a][b][m][n] = (f32x4){0.f, 0.f, 0.f, 0.f};
        cur = nxt; ++ui;
        if constexpr (GA) { const u32x4 q = *mystash; voG[0][0] = q.x; voG[0][1] = q.y; voG[1][0] = q.z; voG[1][1] = q.w; } else cA = nA;
        if (wr == 1) PG8_BAR;
    }
    PG8_WAIT_V(0);
    PG8_BAR;
#undef PG8_SA
#undef PG8_SB
#undef PG8_STAGE2
#undef PG8_STAGEB
#undef PG8_STAGEA
#undef PG8_LDA
#undef PG8_LDB
#undef PG8_MMA
#undef PG8_WAIT_V
#undef PG8_WAIT_L
#undef PG8_BAR
#undef PG8_SCHED
}

template <int K_, int LDA_, int EB_ = 2> struct DenseSched : StaticOrder {
    static constexpr int K = K_, LDB = K_, LDA = LDA_, EB = EB_; static constexpr bool GATHER = false;
    const char* A; const char* Bt;
    __device__ __forceinline__ const char* a_ptr(const Unit& u) const { return A + (size_t)u.pm * BM * LDA_ * EB_; }
    __device__ __forceinline__ const char* b_ptr(const Unit& u, int t) const { return Bt + (size_t)u.pn * BM * K_ * EB_ + (size_t)t * 128; }
};
struct UOrder {
    static constexpr int K = PLE, LDB = PLE, LDB2 = PLE, LDA = PLE, EB = 2; static constexpr bool GATHER = false;
    const char* A; const char* Bt; int first, stride, count;
    __device__ __forceinline__ void a_ready(const Unit&, int) const {}
    __device__ __forceinline__ void done(const Unit&, int) const {}
    __device__ __forceinline__ bool alt(const Unit&) const { return false; }
    __device__ __forceinline__ bool next(int i, Unit& u) const { if (i >= count) return false; const int L = first + i * stride; u.pm = L >> 2; u.pn = L & 3; u.ea = 0; u.eb = 0; u.b = 0; u.base = 0; u.cnt = 0; return true; }
    __device__ __forceinline__ const char* a_ptr(const Unit& u) const { return A + (size_t)u.pm * BM * PLE * 2; }
    __device__ __forceinline__ const char* b_ptr(const Unit& u, int t) const { return Bt + (size_t)u.pn * BM * PLE * 2 + (size_t)t * (BK * 2); }
};
__device__ __forceinline__ void tile_info(const LAS int* tt, Unit& u) {
    const int b = __builtin_amdgcn_readfirstlane(tt[u.pm * 4]), base = __builtin_amdgcn_readfirstlane(tt[u.pm * 4 + 1]), cnt = __builtin_amdgcn_readfirstlane(tt[u.pm * 4 + 2]);
    u.b = b; u.base = base; u.cnt = cnt; bucket_experts(b, u.ea, u.eb);
}
struct Moe1Sched : StaticOrder {
    static constexpr int K = DM, LDA = DM, LDB = DM, EB = 1; static constexpr bool GATHER = true;
    const char* h1b; const char* W13; const int* list; const LAS int* tt;
    __device__ __forceinline__ bool next(int i, Unit& u) const { if (!StaticOrder::next(i, u)) return false; tile_info(tt, u); return true; }
    __device__ __forceinline__ const char* a_base() const { return h1b; }
    __device__ __forceinline__ void a_goffs(const Unit& u, int tid, unsigned (&vo)[2][2]) const {
#pragma unroll
        for (int i = 0; i < 2; ++i) { int R, C; stage_rc(tid * 16 + i * 8192, R, C);
#pragma unroll
            for (int h = 0; h < 2; ++h) { const int pos = u.pm * BM - u.base + h * HALF + R; const int tok = pos < u.cnt ? list[((size_t)u.b * T + pos) * 4] : 0; vo[h][i] = (unsigned)(tok * DM + C * 2); } }
    }
    __device__ __forceinline__ const char* b_ptr(const Unit& u, int t) const { const int e = u.pn < 4 ? u.ea : u.eb; return W13 + (size_t)e * (1024 * 1024) + (size_t)(u.pn & 3) * (BM * DM) + (size_t)t * 128; }
};
struct Moe2Sched : StaticOrder {
    static constexpr int K = 1024, LDA = 1024, LDB = FF, EB = 1; static constexpr bool GATHER = false;
    const char* H; const char* W2; const LAS int* tt;
    __device__ __forceinline__ bool next(int i, Unit& u) const { if (!StaticOrder::next(i, u)) return false; tile_info(tt, u); return true; }
    __device__ __forceinline__ const char* a_ptr(const Unit& u) const { return H + (size_t)u.pm * BM * 1024; }
    __device__ __forceinline__ const char* b_ptr(const Unit& u, int t) const { const int e = t < 4 ? u.ea : u.eb; return W2 + (size_t)e * (DM * FF) + (size_t)u.pn * (BM * FF) + (size_t)(t & 3) * 128; }
};

__device__ __forceinline__ float fast_sigmoid(float v) { return __builtin_amdgcn_rcpf(1.0f + __builtin_amdgcn_exp2f(-1.4426950408889634f * v)); }
__device__ __forceinline__ void unpack8(u32x4 v, float (&f)[8]) { f[0] = __uint_as_float(v.x << 16); f[1] = __uint_as_float(v.x & 0xffff0000u); f[2] = __uint_as_float(v.y << 16); f[3] = __uint_as_float(v.y & 0xffff0000u);
    f[4] = __uint_as_float(v.z << 16); f[5] = __uint_as_float(v.z & 0xffff0000u); f[6] = __uint_as_float(v.w << 16); f[7] = __uint_as_float(v.w & 0xffff0000u); }
struct EpiZ {
    unsigned char* ws; const float* q_norm; const float* k_norm; const float* rinvx;
    __device__ __forceinline__ void operator()(const f32x4 (&acc)[2][2][4][2], const Unit& u, int wr, int wc, int fr, int fq) const {
        const int region = u.pn >> 1, cbase = (u.pn & 1) * 256 + wc * 64 + 8 * fq;
        bf16_t* base = (bf16_t*)(ws + WS_Q + (size_t)region * (32 * MiB));
        const int row0 = u.pm * BM + wr * 64 + fr;
        float rx[2][4];
#pragma unroll
        for (int ai = 0; ai < 2; ++ai)
#pragma unroll
            for (int m = 0; m < 4; ++m) rx[ai][m] = rinvx[row0 + ai * HALF + m * 16];
        if (region < 2) {
            const float* gp = region ? k_norm : q_norm; const float qs = region ? 1.0f : 0.125f * 1.4426950408889634f;
            f32x4 g[2][2];
#pragma unroll
            for (int bj = 0; bj < 2; ++bj)
#pragma unroll
                for (int n = 0; n < 2; ++n) g[bj][n] = *(const f32x4*)(gp + 32 * bj + 8 * fq + 4 * n) * qs;
            const float* ropet = (const float*)(ws + WS_ROPE);
            f32x4 ncs0, ncs1, nsn0, nsn1;
            { const int pos = row0 & (SEQ - 1); ncs0 = *(const f32x4*)(ropet + (size_t)pos * 8); ncs1 = *(const f32x4*)(ropet + (size_t)pos * 8 + 4); nsn0 = *(const f32x4*)(ropet + 65536 + (size_t)pos * 8); nsn1 = *(const f32x4*)(ropet + 65536 + (size_t)pos * 8 + 4); }
#pragma unroll
            for (int ai = 0; ai < 2; ++ai)
#pragma unroll
                for (int m = 0; m < 4; ++m) {
                    const int r = row0 + ai * HALF + m * 16;
                    const f32x4 cs0 = ncs0, cs1 = ncs1, sn0 = nsn0, sn1 = nsn1;
                    if (ai * 4 + m < 7) { const int g1 = ai * 4 + m + 1; const int pos = (row0 + (g1 >> 2) * HALF + (g1 & 3) * 16) & (SEQ - 1);
                        ncs0 = *(const f32x4*)(ropet + (size_t)pos * 8); ncs1 = *(const f32x4*)(ropet + (size_t)pos * 8 + 4); nsn0 = *(const f32x4*)(ropet + 65536 + (size_t)pos * 8); nsn1 = *(const f32x4*)(ropet + 65536 + (size_t)pos * 8 + 4); }
                    f32x4 v[2][2]; float ss = 0.f;
#pragma unroll
                    for (int bj = 0; bj < 2; ++bj)
#pragma unroll
                        for (int n = 0; n < 2; ++n) { const f32x4 x = acc[ai][bj][m][n] * rx[ai][m]; v[bj][n] = x; ss += (x[0] * x[0] + x[1] * x[1]) + (x[2] * x[2] + x[3] * x[3]); }
                    ss += __shfl_xor(ss, 16); ss += __shfl_xor(ss, 32);
                    const float ri = 1.0f / sqrtf(ss * (1.0f / 64.f) + EPS);
#pragma unroll
                    for (int bj = 0; bj < 2; ++bj)
#pragma unroll
                        for (int n = 0; n < 2; ++n) v[bj][n] = v[bj][n] * ri * g[bj][n];
#pragma unroll
                    for (int n = 0; n < 2; ++n) {
                        const f32x4 cs = n ? cs1 : cs0, sn = n ? sn1 : sn0;
#pragma unroll
                        for (int e = 0; e < 4; ++e) {
                            const float own = v[0][n][e], partner = __shfl_xor(own, 16);
                            const float rot = fq == 0 ? own * cs[e] - partner * sn[e] : own * cs[e] + partner * sn[e];
                            v[0][n][e] = fq < 2 ? rot : own;
                        }
                    }
                    bf16_t* rowp = base + (size_t)r * AW + cbase;
#pragma unroll
                    for (int bj = 0; bj < 2; ++bj) { u32x4 w; w.x = cvt_pk_bf16(v[bj][0][0], v[bj][0][1]); w.y = cvt_pk_bf16(v[bj][0][2], v[bj][0][3]); w.z = cvt_pk_bf16(v[bj][1][0], v[bj][1][1]); w.w = cvt_pk_bf16(v[bj][1][2], v[bj][1][3]);
                        *(u32x4*)(rowp + 32 * bj) = w; }
                }
        } else if (u.pn >= 8) {
            bf16_t* ub = (bf16_t*)(ws + WS_CC) + (u.pn - 8) * 128 + wc * 32 + 8 * fq;
#pragma unroll
            for (int ai = 0; ai < 2; ++ai)
#pragma unroll
                for (int m = 0; m < 4; ++m) { const float s2 = rx[ai][m] * rx[ai][m]; const f32x4 v0 = acc[ai][0][m][0] * acc[ai][1][m][0] * s2, v1 = acc[ai][0][m][1] * acc[ai][1][m][1] * s2;
                    u32x4 w; w.x = cvt_pk_bf16(v0[0], v0[1]); w.y = cvt_pk_bf16(v0[2], v0[3]); w.z = cvt_pk_bf16(v1[0], v1[1]); w.w = cvt_pk_bf16(v1[2], v1[3]);
                    *(u32x4*)(ub + (size_t)(row0 + ai * HALF + m * 16) * AW) = w; }
        } else {
#pragma unroll
            for (int ai = 0; ai < 2; ++ai)
#pragma unroll
                for (int m = 0; m < 4; ++m) { bf16_t* rowp = base + (size_t)(row0 + ai * HALF + m * 16) * AW + cbase; const float s = rx[ai][m];
#pragma unroll
                    for (int bj = 0; bj < 2; ++bj) { const f32x4 v0 = acc[ai][bj][m][0] * s, v1 = acc[ai][bj][m][1] * s; u32x4 w; w.x = cvt_pk_bf16(v0[0], v0[1]); w.y = cvt_pk_bf16(v0[2], v0[3]); w.z = cvt_pk_bf16(v1[0], v1[1]); w.w = cvt_pk_bf16(v1[2], v1[3]);
                        *(u32x4*)(rowp + 32 * bj) = w; } }
        }
    }
};
struct EpiU {
    bf16_t* U; float* ssq; const float* gpost;
    __device__ __forceinline__ void operator()(const f32x4 (&acc)[2][2][4][2], const Unit& u, int wr, int wc, int fr, int fq) const {
        const int row0 = u.pm * BM + wr * 64 + fr, col0 = u.pn * BM + wc * 32 + 8 * fq;
        f32x4 gv[2][2];
#pragma unroll
        for (int bj = 0; bj < 2; ++bj)
#pragma unroll
            for (int n = 0; n < 2; ++n) gv[bj][n] = *(const f32x4*)(gpost + col0 + bj * HALF + 4 * n);
#pragma unroll
        for (int ai = 0; ai < 2; ++ai)
#pragma unroll
            for (int m = 0; m < 4; ++m) { const int r = row0 + ai * HALF + m * 16; bf16_t* rowp = U + (size_t)r * DM + col0; float ss = 0.f;
#pragma unroll
                for (int bj = 0; bj < 2; ++bj) { const f32x4 v0 = acc[ai][bj][m][0], v1 = acc[ai][bj][m][1];
                    ss += (v0[0] * v0[0] + v0[1] * v0[1]) + (v0[2] * v0[2] + v0[3] * v0[3]) + (v1[0] * v1[0] + v1[1] * v1[1]) + (v1[2] * v1[2] + v1[3] * v1[3]);
                    const f32x4 g0 = v0 * gv[bj][0], g1 = v1 * gv[bj][1];
                    u32x4 w; w.x = cvt_pk_bf16(g0[0], g0[1]); w.y = cvt_pk_bf16(g0[2], g0[3]); w.z = cvt_pk_bf16(g1[0], g1[1]); w.w = cvt_pk_bf16(g1[2], g1[3]);
                    *(u32x4*)(rowp + bj * HALF) = w; }
                ss += __shfl_xor(ss, 16); ss += __shfl_xor(ss, 32);
                if (fq == 0) ssq[(size_t)r * 16 + u.pn * 4 + wc] = ss; }
    }
};

struct EpiO {
    const bf16_t* xb; bf16_t* h1b; unsigned char* h1f8;
    __device__ __forceinline__ void operator()(const f32x4 (&acc)[2][2][4][2], const Unit& u, int wr, int wc, int fr, int fq) const {
        const int row0 = u.pm * BM + wr * 64 + fr, col0 = u.pn * BM + wc * 32 + 8 * fq;
        u32x4 nx0 = *(const u32x4*)(xb + (size_t)row0 * DM + col0), nx1 = *(const u32x4*)(xb + (size_t)row0 * DM + col0 + HALF);
#pragma unroll
        for (int g = 0; g < 8; ++g) { const int ai = g >> 2, m = g & 3; const size_t off = (size_t)(row0 + ai * HALF + m * 16) * DM + col0;
            const u32x4 x0 = nx0, x1 = nx1;
            if (g < 7) { const size_t o2 = (size_t)(row0 + ((g + 1) >> 2) * HALF + ((g + 1) & 3) * 16) * DM + col0; nx0 = *(const u32x4*)(xb + o2); nx1 = *(const u32x4*)(xb + o2 + HALF); }
#pragma unroll
            for (int bj = 0; bj < 2; ++bj) { float hv[8]; unpack8(bj ? x1 : x0, hv);
#pragma unroll
                for (int n = 0; n < 2; ++n)
#pragma unroll
                    for (int e = 0; e < 4; ++e) hv[4 * n + e] += acc[ai][bj][m][n][e];
                u32x4 w; w.x = cvt_pk_bf16(hv[0], hv[1]); w.y = cvt_pk_bf16(hv[2], hv[3]); w.z = cvt_pk_bf16(hv[4], hv[5]); w.w = cvt_pk_bf16(hv[6], hv[7]); *(u32x4*)(h1b + off + bj * HALF) = w;
                u32x2 w8; w8.x = pk4_fp8(hv[0] * F8_SA, hv[1] * F8_SA, hv[2] * F8_SA, hv[3] * F8_SA); w8.y = pk4_fp8(hv[4] * F8_SA, hv[5] * F8_SA, hv[6] * F8_SA, hv[7] * F8_SA); *(u32x2*)(h1f8 + off + bj * HALF) = w8; } }
    }
};
struct EpiM1 {
    unsigned char* H; const u32x4* rec;
    __device__ __forceinline__ void operator()(const f32x4 (&acc)[2][2][4][2], const Unit& u, int wr, int wc, int fr, int fq) const {
        const int rl0 = wr * 64 + fr, col0 = (u.pn >> 2) * 512 + (u.pn & 3) * 128 + wc * 32 + 8 * fq;
        const int pos0 = u.pm * BM - u.base; const u32x4* rb = rec + (size_t)u.b * T; const bool ea = u.pn < 4;
        float riv[2][4], gtv[2][4];
#pragma unroll
        for (int ai = 0; ai < 2; ++ai)
#pragma unroll
            for (int m = 0; m < 4; ++m) { const int pos = pos0 + rl0 + ai * HALF + m * 16; const bool ok = pos < u.cnt; const u32x4 q = rb[ok ? pos : 0];
                riv[ai][m] = ok ? __uint_as_float(q.y) : 0.f; gtv[ai][m] = ok ? __uint_as_float(ea ? q.z : q.w) : 0.f; }
#pragma unroll
        for (int ai = 0; ai < 2; ++ai)
#pragma unroll
            for (int m = 0; m < 4; ++m) { const int sr = u.pm * BM + rl0 + ai * HALF + m * 16; const float ri = riv[ai][m], gate = gtv[ai][m];
                float o[8];
#pragma unroll
                for (int n = 0; n < 2; ++n)
#pragma unroll
                    for (int e = 0; e < 4; ++e) { const float a = acc[ai][0][m][n][e] * ri, b = acc[ai][1][m][n][e] * ri; o[4 * n + e] = gate * (a * fast_sigmoid(a)) * b; }
                u32x2 w; w.x = pk4_fp8(o[0], o[1], o[2], o[3]); w.y = pk4_fp8(o[4], o[5], o[6], o[7]);
                *(u32x2*)(H + (size_t)sr * 1024 + col0) = w; }
    }
};
struct EpiM2 {
    const bf16_t* h1b; bf16_t* h2b; float* ssq; const int* list; unsigned char* h2f8;
    __device__ __forceinline__ void operator()(const f32x4 (&acc)[2][2][4][2], const Unit& u, int wr, int wc, int fr, int fq) const {
        const int rl0 = wr * 64 + fr, col0 = u.pn * BM + wc * 32 + 8 * fq; const int pos0 = u.pm * BM - u.base; const int* lb = list + (size_t)u.b * T * 4;
        int tok[2][4];
#pragma unroll
        for (int ai = 0; ai < 2; ++ai)
#pragma unroll
            for (int m = 0; m < 4; ++m) { const int pos = pos0 + rl0 + ai * HALF + m * 16; tok[ai][m] = pos < u.cnt ? lb[pos * 4] : -1; }
        u32x4 n0, n1;
        { const int t0 = tok[0][0]; const size_t o0 = (size_t)(t0 >= 0 ? t0 : 0) * DM + col0; n0 = *(const u32x4*)(h1b + o0); n1 = *(const u32x4*)(h1b + o0 + HALF); }
#pragma unroll
        for (int g = 0; g < 8; ++g) { const int ai = g >> 2, m = g & 3; const int tk = tok[ai][m]; const bool ok = tk >= 0; const size_t off = (size_t)(ok ? tk : 0) * DM + col0;
                const u32x4 hb0 = n0, hb1 = n1; float ss = 0.f;
                if (g < 7) { const int t2 = tok[(g + 1) >> 2][(g + 1) & 3]; const size_t o2 = (size_t)(t2 >= 0 ? t2 : 0) * DM + col0; n0 = *(const u32x4*)(h1b + o2); n1 = *(const u32x4*)(h1b + o2 + HALF); }
#pragma unroll
                for (int bj = 0; bj < 2; ++bj) { float hv[8]; unpack8(bj ? hb1 : hb0, hv);
#pragma unroll
                    for (int n = 0; n < 2; ++n)
#pragma unroll
                        for (int e = 0; e < 4; ++e) { hv[4 * n + e] += acc[ai][bj][m][n][e] * (1.0f / (F8_SH * F8_SW2)); ss += hv[4 * n + e] * hv[4 * n + e]; }
                    u32x4 w; w.x = cvt_pk_bf16(hv[0], hv[1]); w.y = cvt_pk_bf16(hv[2], hv[3]); w.z = cvt_pk_bf16(hv[4], hv[5]); w.w = cvt_pk_bf16(hv[6], hv[7]);
                    if (ok) { *(u32x4*)(h2b + off + bj * HALF) = w;
                        u32x2 w8; w8.x = pk4_fp8(hv[0] * F8_SA2, hv[1] * F8_SA2, hv[2] * F8_SA2, hv[3] * F8_SA2); w8.y = pk4_fp8(hv[4] * F8_SA2, hv[5] * F8_SA2, hv[6] * F8_SA2, hv[7] * F8_SA2); *(u32x2*)(h2f8 + off + bj * HALF) = w8; } }
                ss += __shfl_xor(ss, 16); ss += __shfl_xor(ss, 32);
                if (ok && fq == 0) ssq[(size_t)tk * 16 + u.pn * 4 + wc] = ss; }
    }
};
struct EpiG {
    float* out; const bf16_t* h2b; const bf16_t* U; const float* ssq2; const float* ssqu;
    __device__ __forceinline__ void operator()(const f32x4 (&acc)[2][2][4][2], const Unit& u, int wr, int wc, int fr, int fq) const {
        const int row0 = u.pm * BM + wr * 64 + fr, col0 = u.pn * BM + wc * 32 + 8 * fq;
        u32x4 bh0[4], bh1[4], bu0[4], bu1[4];
#define EG_ISSUE(G) { const size_t o_ = (size_t)(row0 + ((G) >> 2) * HALF + ((G) & 3) * 16) * DM + col0; bh0[(G) & 3] = *(const u32x4*)(h2b + o_); bh1[(G) & 3] = *(const u32x4*)(h2b + o_ + HALF); bu0[(G) & 3] = *(const u32x4*)(U + o_); bu1[(G) & 3] = *(const u32x4*)(U + o_ + HALF); }
        EG_ISSUE(0) EG_ISSUE(1) EG_ISSUE(2)
        float r2v[8], ruv[8];
#pragma unroll
        for (int g = 0; g < 8; ++g) { const int r = row0 + (g >> 2) * HALF + (g & 3) * 16;
            const f32x4 a = *(const f32x4*)(ssq2 + (size_t)r * 16 + 4 * fq), b = *(const f32x4*)(ssqu + (size_t)r * 16 + 4 * fq); float s2 = (a[0] + a[1]) + (a[2] + a[3]), su = (b[0] + b[1]) + (b[2] + b[3]);
            s2 += __shfl_xor(s2, 16); su += __shfl_xor(su, 16); s2 += __shfl_xor(s2, 32); su += __shfl_xor(su, 32);
            r2v[g] = (1.0f / (F8_SA2 * F8_SWG)) / sqrtf(s2 * (1.0f / 1024.f) + EPS); ruv[g] = 1.0f / sqrtf(su * (1.0f / 1024.f) + EPS); }
#pragma unroll
        for (int g = 0; g < 8; ++g) { const int ai = g >> 2, m = g & 3; const int r = row0 + ai * HALF + m * 16; const size_t off = (size_t)r * DM + col0;
                if (g + 3 < 8) EG_ISSUE(g + 3)
                const u32x4 hb0 = bh0[g & 3], hb1 = bh1[g & 3], ub0 = bu0[g & 3], ub1 = bu1[g & 3];
                const float r2 = r2v[g], ru = ruv[g];
#pragma unroll
                for (int bj = 0; bj < 2; ++bj) { float hv[8], uv[8]; unpack8(bj ? hb1 : hb0, hv); unpack8(bj ? ub1 : ub0, uv);
#pragma unroll
                    for (int n = 0; n < 2; ++n) { f32x4 res;
#pragma unroll
                        for (int e = 0; e < 4; ++e) res[e] = hv[4 * n + e] + fast_sigmoid(acc[ai][bj][m][n][e] * r2) * (uv[4 * n + e] * ru);
                        *(f32x4*)(out + off + bj * HALF + 4 * n) = res; } } }
#undef EG_ISSUE
    }
};
}

template <class RowMap>
__device__ __forceinline__ void p0_transpose_item(const float* W, int ldw, bf16_t* WT, int Kdst, LAS float* scr, int k0, int n0, int lane, const float* kscale, RowMap rowmap, float f8scale = 0.f) {
    f32x4 ld[8];
#pragma unroll
    for (int i = 0; i < 8; ++i) ld[i] = *(const f32x4*)(W + (size_t)(k0 + 8 * i + (lane >> 3)) * ldw + n0 + 4 * (lane & 7));
#pragma unroll
    for (int i = 0; i < 8; ++i) { const int kk = 8 * i + (lane >> 3); const float sc = kscale ? kscale[k0 + kk] : 1.0f; LAS float* d = scr + kk * 33 + 4 * (lane & 7);
        d[0] = ld[i].x * sc; d[1] = ld[i].y * sc; d[2] = ld[i].z * sc; d[3] = ld[i].w * sc; }
    asm volatile("s_waitcnt lgkmcnt(0)" ::: "memory");
    const int c = lane & 7;
#pragma unroll
    for (int j = 0; j < 4; ++j) { const int n = (lane >> 3) + 8 * j; const LAS float* s = scr + (8 * c) * 33 + n;
        pg8::u32x4 o; o.x = f2bf(s[0 * 33]) | (f2bf(s[1 * 33]) << 16); o.y = f2bf(s[2 * 33]) | (f2bf(s[3 * 33]) << 16); o.z = f2bf(s[4 * 33]) | (f2bf(s[5 * 33]) << 16); o.w = f2bf(s[6 * 33]) | (f2bf(s[7 * 33]) << 16);
        if (f8scale == 0.f) *(pg8::u32x4*)(WT + (size_t)rowmap(n0 + n) * Kdst + k0 + 8 * c) = o;
        else { pg8::u32x2 o8; o8.x = pg8::pk4_fp8(s[0 * 33] * f8scale, s[1 * 33] * f8scale, s[2 * 33] * f8scale, s[3 * 33] * f8scale); o8.y = pg8::pk4_fp8(s[4 * 33] * f8scale, s[5 * 33] * f8scale, s[6 * 33] * f8scale, s[7 * 33] * f8scale);
            *(pg8::u32x2*)((unsigned char*)WT + (size_t)rowmap(n0 + n) * Kdst + k0 + 8 * c) = o8; } }
    asm volatile("s_waitcnt lgkmcnt(0)" ::: "memory");
}
__device__ __forceinline__ int rm_head(int lc) { const int wc = lc >> 6, d = lc & 63; return 128 * (d >> 5) + 32 * wc + 16 * ((d >> 2) & 1) + 4 * ((d >> 3) & 3) + (d & 3); }
__device__ __forceinline__ int rm_perm(int lc) { const int bj = lc >> 7, wc = (lc >> 5) & 3, j = lc & 31; return 128 * bj + 32 * wc + 16 * ((j >> 2) & 1) + 4 * ((j >> 3) & 3) + (j & 3); }
__device__ __forceinline__ void p0_weights(const P& p, LAS unsigned char* lds, int vw, int nvw, int wave, int lane, int part) {
    LAS float* scr = (LAS float*)(lds + wave * 16384);
    unsigned char* ws = p.ws;
    auto perm = [](int c) { return (c & ~255) + rm_perm(c & 255); };
    constexpr int I_IN = 16 * 96, I_OUT = 16 * 32, I_G = 16 * 32, I_P = 4 * 32, I_1 = 16 * 16 * 16, I_3 = I_1, I_2 = 16 * 8 * 32;
    constexpr int NIT = I_IN + I_OUT + I_G + I_P + I_1 + I_3 + I_2;
    constexpr int NIT0 = I_IN + I_OUT + I_G + I_P;
    const int lo = part == 0 ? 0 : (part == 1 ? I_IN : NIT0 + I_1 + I_3), hi = part == 0 ? I_IN : (part == 1 ? NIT0 + I_1 + I_3 : NIT);
    for (int it = lo + vw; it < hi; it += nvw) {
        int r = it;
        if (r < I_IN) { const int kb = r / 96, nb = r % 96; p0_transpose_item(p.w_in, NZ, (bf16_t*)(ws + WS_WIN), DM, scr, 64 * kb, 32 * nb, lane, p.g_mix, [](int c) {
            if (c < 2048) return (c & ~255) + rm_head(c & 255);
            const int is_ch = c >= 2560, j = (c - 2048) & 511;
            return 256 * (8 + (j >> 7)) + rm_perm(is_ch * 128 + (j & 127)); }); continue; } r -= I_IN;
        if (r < I_OUT) { const int kb = r / 32, nb = r % 32; p0_transpose_item(p.w_out, DM, (bf16_t*)(ws + WS_WOUT), DM, scr, 64 * kb, 32 * nb, lane, nullptr, perm); continue; } r -= I_OUT;
        if (r < I_G) { const int kb = r / 32, nb = r % 32; p0_transpose_item(p.w_ple_gate, DM, (bf16_t*)(ws + WS_WG), DM, scr, 64 * kb, 32 * nb, lane, p.g_ple, perm, pg8::F8_SWG); continue; } r -= I_G;
        if (r < I_P) { const int kb = r / 32, nb = r % 32; p0_transpose_item(p.w_ple_proj, DM, (bf16_t*)(ws + WS_WP), PLE, scr, 64 * kb, 32 * nb, lane, nullptr, perm); continue; } r -= I_P;
        if (r < I_1 + I_3) {
            const int is3 = r >= I_1; if (is3) r -= I_1;
            const int e = r / 256, kb = (r % 256) / 16, nb = r % 16;
            const float* W = (is3 ? p.w3 : p.w1) + (size_t)e * DM * FF;
            bf16_t* WT = (bf16_t*)(ws + WS_W13 + (size_t)e * 1024 * DM);
            p0_transpose_item(W, FF, WT, DM, scr, 64 * kb, 32 * nb, lane, p.g_ffn, [is3](int j) { const int q = j >> 7, jl = j & 127; return 256 * q + rm_perm(is3 * 128 + jl); }, pg8::F8_SW1);
            continue; } r -= I_1 + I_3;
        { const int e = r / 256, kb = (r % 256) / 32, nb = r % 32;
          p0_transpose_item(p.w2 + (size_t)e * FF * DM, DM, (bf16_t*)(ws + WS_W2 + (size_t)e * DM * FF), FF, scr, 64 * kb, 32 * nb, lane, nullptr, perm, pg8::F8_SW2); }
    }
}
__device__ __forceinline__ void p0_rope(const P& p, int gw, int ngw, int lane);
__device__ __forceinline__ void p0_prologue(const P& p, LAS unsigned char* lds, int gw, int ngw, int wave, int lane) {
    unsigned char* ws = p.ws;
    p0_weights(p, lds, gw, ngw, wave, lane, 0);
    p0_rope(p, gw, ngw, lane);
    { bf16_t* xb = (bf16_t*)(ws + WS_XB); float* rinvx = (float*)(ws + WS_RINVX);
      for (int r = gw; r < T; r += 4 * ngw) {
          f32x4 v[4][4]; float a[4];
#pragma unroll
          for (int q = 0; q < 4; ++q) { const f32x4* s0 = (const f32x4*)(p.x + (size_t)(r + q * ngw) * DM);
#pragma unroll
              for (int j = 0; j < 4; ++j) v[q][j] = s0[lane + 64 * j]; }
#pragma unroll
          for (int q = 0; q < 4; ++q) { a[q] = 0.f;
#pragma unroll
              for (int j = 0; j < 4; ++j) a[q] += v[q][j].x * v[q][j].x + v[q][j].y * v[q][j].y + v[q][j].z * v[q][j].z + v[q][j].w * v[q][j].w; }
#pragma unroll
          for (int o = 1; o < 64; o <<= 1) {
#pragma unroll
              for (int q = 0; q < 4; ++q) a[q] += __shfl_xor(a[q], o); }
#pragma unroll
          for (int q = 0; q < 4; ++q) { if (lane == 0) rinvx[r + q * ngw] = 1.0f / sqrtf(a[q] * (1.0f / 1024.f) + EPS);
#pragma unroll
              for (int j = 0; j < 4; ++j) { pg8::u32x2 w0; w0.x = pg8::cvt_pk_bf16(v[q][j].x, v[q][j].y); w0.y = pg8::cvt_pk_bf16(v[q][j].z, v[q][j].w); *(pg8::u32x2*)(xb + (size_t)(r + q * ngw) * DM + 4 * (lane + 64 * j)) = w0; } }
      } }
}
__device__ __forceinline__ void p0_late(const P& p, int gw, int ngw, int lane) {
    unsigned char* ws = p.ws;
    { const size_t n8 = (size_t)T * PLE / 8, stride = (size_t)ngw * 64; bf16_t* pb = (bf16_t*)(ws + WS_PB);
      for (size_t i = (size_t)gw * 64 + lane; i < n8; i += 4 * stride) {
          f32x4 a[4], b[4];
#pragma unroll
          for (int q = 0; q < 4; ++q) { a[q] = ((const f32x4*)p.p)[2 * (i + q * stride)]; b[q] = ((const f32x4*)p.p)[2 * (i + q * stride) + 1]; }
#pragma unroll
          for (int q = 0; q < 4; ++q) { pg8::u32x4 o; o.x = pg8::cvt_pk_bf16(a[q].x, a[q].y); o.y = pg8::cvt_pk_bf16(a[q].z, a[q].w); o.z = pg8::cvt_pk_bf16(b[q].x, b[q].y); o.w = pg8::cvt_pk_bf16(b[q].z, b[q].w); ((pg8::u32x4*)pb)[i + q * stride] = o; } } }
    { for (int idx = gw * 64 + lane; idx < 32 * 2 * 64; idx += ngw * 64) { const int ks = idx >> 7, ct = (idx >> 6) & 1, l = idx & 63, e = 16 * ct + (l & 15), kq = l >> 4;
          unsigned hi[8], lo[8];
#pragma unroll
          for (int j = 0; j < 8; ++j) { const int k = 32 * ks + 8 * kq + j; float w = e < 4 ? p.w_rg[k * 4 + e] : (e < 20 ? p.w_re[k * 16 + (e - 4)] : 0.f); w *= p.g_ffn[k]; hi[j] = f2bf(w); lo[j] = f2bf(w - bf2f(hi[j])); }
          pg8::u32x4 oh, ol; oh.x = hi[0] | (hi[1] << 16); oh.y = hi[2] | (hi[3] << 16); oh.z = hi[4] | (hi[5] << 16); oh.w = hi[6] | (hi[7] << 16); ol.x = lo[0] | (lo[1] << 16); ol.y = lo[2] | (lo[3] << 16); ol.z = lo[4] | (lo[5] << 16); ol.w = lo[6] | (lo[7] << 16);
          ((pg8::u32x4*)(ws + WS_WRH))[idx] = oh; ((pg8::u32x4*)(ws + WS_WRL))[idx] = ol; } }
}
__device__ __forceinline__ void p0_rope(const P& p, int gw, int ngw, int lane) {
    unsigned char* ws = p.ws;
    { float* rt = (float*)(ws + WS_ROPE);
      for (int i = gw * 64 + lane; i < SEQ * 8; i += ngw * 64) { const int pos = i >> 3, fi = i & 7; float inv = p.inv_freq[0];
#pragma unroll
          for (int q = 1; q < 8; ++q) inv = (fi == q) ? p.inv_freq[q] : inv;
          const float ang = (float)pos * inv; rt[i] = cosf(ang); rt[65536 + i] = sinf(ang); } }
}

namespace att {
typedef unsigned u32x4 __attribute__((ext_vector_type(4)));
}
namespace att {
typedef short bf16x8 __attribute__((ext_vector_type(8)));
typedef short s16x4 __attribute__((ext_vector_type(4)));
typedef unsigned u32x4 __attribute__((ext_vector_type(4)));
constexpr int VPITCH = 192, OPITCH = 144, KPITCH = 144;
__device__ __forceinline__ int crow(int r, int hi) { return (r & 3) + 8 * (r >> 2) + 4 * hi; }
__device__ __forceinline__ unsigned cvtpk(float lo, float hi) { unsigned r; asm volatile("v_cvt_pk_bf16_f32 %0, %1, %2" : "=v"(r) : "v"(lo), "v"(hi)); return r; }
typedef float f32x2_t __attribute__((ext_vector_type(2))); typedef __bf16 bf16x2_t __attribute__((ext_vector_type(2)));
__device__ __forceinline__ unsigned cvtpk_c(float lo, float hi) { f32x2_t v = {lo, hi}; bf16x2_t b = __builtin_convertvector(v, bf16x2_t); return __builtin_bit_cast(unsigned, b); }
__device__ __forceinline__ s16x4 vtr(LAS unsigned char* p) { return __builtin_bit_cast(s16x4, __builtin_amdgcn_ds_read_tr16_b64_v4i16((LAS s16x4*)p)); }

struct AttLane { int kr[4], vr0, vr1; };
template <int C>
__device__ __forceinline__ void att_compute(LAS unsigned char* buf, const AttLane& L, const bf16x8 (&qf)[4], f32x16& o0, f32x16& o1, float& lsum, float bref, int i, int hi) {
    bf16x8 kf[4]; s16x4 vl[2][4];
#pragma unroll
    for (int d0 = 0; d0 < 4; ++d0) kf[d0] = *(LAS bf16x8*)(buf + L.kr[d0]);
#pragma unroll
    for (int q = 0; q < 4; ++q) { vl[0][q] = vtr(buf + 4096 + L.vr0 + q * 1024); vl[1][q] = vtr(buf + 4096 + L.vr1 + q * 1024); }
    asm volatile("s_waitcnt lgkmcnt(0)" ::: "memory");
    f32x16 sa;
#pragma unroll
    for (int r = 0; r < 16; ++r) sa[r] = -bref;
#pragma unroll
    for (int d0 = 0; d0 < 4; ++d0) sa = __builtin_amdgcn_mfma_f32_32x32x16_bf16(kf[d0], qf[d0], sa, 0, 0, 0);
    float pv[16];
#pragma unroll
    for (int r = 0; r < 16; ++r) pv[r] = __builtin_amdgcn_exp2f(sa[r]);
    if (C == 0) {
#pragma unroll
        for (int r = 0; r < 16; ++r) pv[r] = (crow(r, hi) >= i) ? pv[r] : 0.f;
    }
    if (C == 4) {
#pragma unroll
        for (int r = 0; r < 16; ++r) pv[r] = (crow(r, hi) <= i) ? pv[r] : 0.f;
    }
    float ls = 0.f;
#pragma unroll
    for (int r = 0; r < 16; ++r) ls += pv[r];
    lsum += ls;
    u32x4 w0, w1;
    w0.x = cvtpk(pv[0], pv[1]); w0.y = cvtpk(pv[2], pv[3]); w0.z = cvtpk(pv[4], pv[5]); w0.w = cvtpk(pv[6], pv[7]);
    w1.x = cvtpk(pv[8], pv[9]); w1.y = cvtpk(pv[10], pv[11]); w1.z = cvtpk(pv[12], pv[13]); w1.w = cvtpk(pv[14], pv[15]);
    const bf16x8 pa0 = __builtin_bit_cast(bf16x8, w0), pa1 = __builtin_bit_cast(bf16x8, w1);
#define ATT_VB(dh, s2) (bf16x8){vl[dh][2 * (s2)][0], vl[dh][2 * (s2)][1], vl[dh][2 * (s2)][2], vl[dh][2 * (s2)][3], vl[dh][2 * (s2) + 1][0], vl[dh][2 * (s2) + 1][1], vl[dh][2 * (s2) + 1][2], vl[dh][2 * (s2) + 1][3]}
    o0 = __builtin_amdgcn_mfma_f32_32x32x16_bf16(ATT_VB(0, 0), pa0, o0, 0, 0, 0); o1 = __builtin_amdgcn_mfma_f32_32x32x16_bf16(ATT_VB(1, 0), pa0, o1, 0, 0, 0);
    o0 = __builtin_amdgcn_mfma_f32_32x32x16_bf16(ATT_VB(0, 1), pa1, o0, 0, 0, 0); o1 = __builtin_amdgcn_mfma_f32_32x32x16_bf16(ATT_VB(1, 1), pa1, o1, 0, 0, 0);
#undef ATT_VB
}
struct GroupInfo { int dsh, dd, pos0, h, b, s0; size_t tb; };
__device__ __forceinline__ GroupInfo att_group(int k, int blk) {
    const int x = blk & 7, m = blk >> 3; GroupInfo g; g.b = k % 3; const int bh = x + 8 * (k / 3);
    g.h = bh & 7; g.tb = (size_t)(bh >> 3) * SEQ; g.dsh = 2 * g.b; g.dd = 1 << g.dsh;
    const int gper = 32 >> g.dsh, rho = m / gper;
    g.s0 = 8 * (m % gper); g.pos0 = rho + (g.s0 << (5 + g.dsh)); return g;
}
template <int ABL>
__device__ __forceinline__ void attn_phase(const P& p, LAS unsigned char* lds, int gw, int ngw, int wave, int lane) {
    const bf16_t* Q = (const bf16_t*)(p.ws + WS_Q); const bf16_t* Kb = (const bf16_t*)(p.ws + WS_K); const bf16_t* Vb = (const bf16_t*)(p.ws + WS_V);
    LAS unsigned char* obuf = lds + 98304 + wave * 4096;
    const int i = lane & 31, hi = lane >> 5, tid = wave * 64 + lane, blk = (int)blockIdx.x;
    float bref;
    { float a = fabsf(p.q_norm[lane]), b = fabsf(p.k_norm[lane]);
#pragma unroll
      for (int o = 1; o < 64; o <<= 1) { a = fmaxf(a, __shfl_xor(a, o)); b = fmaxf(b, __shfl_xor(b, o)); }
      bref = a * b * (8.0f * 1.4426950408889634f * 1.02f) + 0.25f; }
    AttLane L;
    {
#pragma unroll
      for (int d0 = 0; d0 < 4; ++d0) L.kr[d0] = i * 128 + (((2 * d0 + hi) ^ ((i >> 1) & 7)) << 4);
      const int q_ = (lane & 15) >> 2, p_ = lane & 3, cl = 2 * ((lane >> 4) & 1) + (p_ >> 1), sw4 = ((q_ >> 1) & 1) << 2, rowb = (4 * hi + q_) * 128 + (p_ & 1) * 8;
      L.vr0 = rowb + (((0 ^ sw4) + cl) << 4); L.vr1 = rowb + (((4 ^ sw4) + cl) << 4); }
    const int skv = tid >> 8, srow = (tid >> 3) & 31, sch = tid & 7;
    const int sdst = skv * 4096 + srow * 128 + ((skv ? (sch ^ (((srow >> 1) & 1) << 2)) : (sch ^ ((srow >> 1) & 7))) << 4);
    const bf16_t* sbase = skv ? Vb : Kb;
    constexpr int NROUND = 12;
    u32x4 st[12]; bf16x8 qf[4], qn[4];
#define ATT_GLOAD(g, QD) do { \
        _Pragma("unroll") for (int j = 0; j < 12; ++j) { int pt_ = (g).pos0 + (32 * (j - 4) + srow) * (g).dd; pt_ = pt_ < 0 ? 0 : pt_; st[j] = *(const u32x4*)(sbase + ((g).tb + pt_) * AW + (g).h * 64 + sch * 8); } \
        { const bf16_t* qrow_ = Q + ((g).tb + (g).pos0 + (32 * wave + i) * (g).dd) * AW + (g).h * 64 + 8 * hi; \
          _Pragma("unroll") for (int d0 = 0; d0 < 4; ++d0) QD[d0] = *(const bf16x8*)(qrow_ + 16 * d0); } } while (0)
    GroupInfo cur = att_group(0, blk);
    ATT_GLOAD(cur, qf);
    for (int k = 0; k < NROUND; ++k) {
#pragma unroll
        for (int j = 0; j < 12; ++j) *(LAS u32x4*)(lds + j * 8192 + sdst) = st[j];
        const GroupInfo nx = att_group(k + 1 < NROUND ? k + 1 : k, blk);
        asm volatile("s_waitcnt lgkmcnt(0)" ::: "memory"); __builtin_amdgcn_s_barrier(); asm volatile("" ::: "memory");
        f32x16 o0, o1;
#pragma unroll
        for (int r = 0; r < 16; ++r) { o0[r] = 0.f; o1[r] = 0.f; }
        float lsum = 0.f;
        const int s = cur.s0 + wave, cmin = s >= 4 ? 0 : 4 - s;
        LAS unsigned char* tb0 = lds + wave * 8192;
#define ATT_GLD3(j0) do { _Pragma("unroll") for (int j = (j0); j < (j0) + 3; ++j) { int pt_ = nx.pos0 + (32 * (j - 4) + srow) * nx.dd; pt_ = pt_ < 0 ? 0 : pt_; st[j] = *(const u32x4*)(sbase + (nx.tb + pt_) * AW + nx.h * 64 + sch * 8); } \
        __builtin_amdgcn_sched_barrier(0); } while (0)
        ATT_GLD3(0);
        if (cmin <= 0) att_compute<0>(tb0, L, qf, o0, o1, lsum, bref, i, hi);
        __builtin_amdgcn_sched_barrier(0); ATT_GLD3(3);
        if (cmin <= 1) att_compute<1>(tb0 + 8192, L, qf, o0, o1, lsum, bref, i, hi);
        __builtin_amdgcn_sched_barrier(0); ATT_GLD3(6);
        if (cmin <= 2) att_compute<2>(tb0 + 2 * 8192, L, qf, o0, o1, lsum, bref, i, hi);
        __builtin_amdgcn_sched_barrier(0); ATT_GLD3(9);
        if (cmin <= 3) att_compute<3>(tb0 + 3 * 8192, L, qf, o0, o1, lsum, bref, i, hi);
        __builtin_amdgcn_sched_barrier(0);
        { const bf16_t* qrow_ = Q + (nx.tb + nx.pos0 + (32 * wave + i) * nx.dd) * AW + nx.h * 64 + 8 * hi;
#pragma unroll
          for (int d0 = 0; d0 < 4; ++d0) qn[d0] = *(const bf16x8*)(qrow_ + 16 * d0); }
        __builtin_amdgcn_sched_barrier(0);
        att_compute<4>(tb0 + 4 * 8192, L, qf, o0, o1, lsum, bref, i, hi);
#undef ATT_GLD3
        lsum += __shfl_xor(lsum, 32);
        const int qpos0 = cur.pos0 + 32 * wave * cur.dd;
        bf16_t* PO = (bf16_t*)(p.ws + WS_PO) + (size_t)cur.b * T * AW; float* PL = (float*)(p.ws + WS_PL) + (size_t)cur.b * T * NH;
#pragma unroll
        for (int q4 = 0; q4 < 4; ++q4) {
            const unsigned long long w0 = (unsigned long long)cvtpk_c(o0[4 * q4], o0[4 * q4 + 1]) | ((unsigned long long)cvtpk_c(o0[4 * q4 + 2], o0[4 * q4 + 3]) << 32);
            const unsigned long long w1 = (unsigned long long)cvtpk_c(o1[4 * q4], o1[4 * q4 + 1]) | ((unsigned long long)cvtpk_c(o1[4 * q4 + 2], o1[4 * q4 + 3]) << 32);
            LAS unsigned char* a = obuf + i * 128 + 8 * hi;
            *(LAS unsigned long long*)(a + ((q4 ^ (i & 7)) << 4)) = w0; *(LAS unsigned long long*)(a + (((4 + q4) ^ (i & 7)) << 4)) = w1; }
        asm volatile("s_waitcnt lgkmcnt(0)" ::: "memory");
#pragma unroll
        for (int it = 0; it < 4; ++it) { const int row = it * 8 + (lane >> 3); const u32x4 v = *(LAS u32x4*)(obuf + row * 128 + (lane & 7) * 16); const int lc = (lane & 7) ^ (row & 7);
            *(u32x4*)(PO + (cur.tb + qpos0 + row * cur.dd) * AW + cur.h * 64 + lc * 8) = v; }
        if (hi == 0) PL[(cur.tb + qpos0 + i * cur.dd) * NH + cur.h] = lsum;
        asm volatile("s_waitcnt lgkmcnt(0)" ::: "memory"); __builtin_amdgcn_s_barrier(); asm volatile("" ::: "memory");
        cur = nx;
#pragma unroll
        for (int d0 = 0; d0 < 4; ++d0) qf[d0] = qn[d0];
    }
#undef ATT_GLOAD
}
__device__ __forceinline__ void mix_phase(const P& p, int gw, int ngw, int lane) {
    const bf16_t* PO = (const bf16_t*)(p.ws + WS_PO); const float* PL = (const float*)(p.ws + WS_PL);
    const bf16_t* CB = (const bf16_t*)(p.ws + WS_CB); const bf16_t* CC = (const bf16_t*)(p.ws + WS_CC); const bf16_t* CH = (const bf16_t*)(p.ws + WS_CH);
    bf16_t* mix = (bf16_t*)(p.ws + WS_XN);
    const int c0 = 8 * lane, hd = lane >> 3;
    float ga[8], gc[8], w0[8], w1[8], w2[8];
#pragma unroll
    for (int e = 0; e < 8; ++e) { ga[e] = p.g_attn_out[c0 + e]; gc[e] = p.g_conv_out[c0 + e]; w0[e] = p.conv_w[c0 + e]; w1[e] = p.conv_w[512 + c0 + e]; w2[e] = p.conv_w[1024 + c0 + e]; }
    auto unpack = [](u32x4 v, float (&f)[8]) { f[0] = __uint_as_float(v.x << 16); f[1] = __uint_as_float(v.x & 0xffff0000u); f[2] = __uint_as_float(v.y << 16); f[3] = __uint_as_float(v.y & 0xffff0000u);
        f[4] = __uint_as_float(v.z << 16); f[5] = __uint_as_float(v.z & 0xffff0000u); f[6] = __uint_as_float(v.w << 16); f[7] = __uint_as_float(v.w & 0xffff0000u); };
    const u32x4 z4 = {0u, 0u, 0u, 0u};
    for (int chunk = gw; chunk < T / 16; chunk += ngw) {
        for (int t = chunk * 16; t < chunk * 16 + 16; t += 2) {
            const int pos = t & (SEQ - 1);
            u32x4 po[2][3]; float pl[2][3];
#pragma unroll
            for (int k = 0; k < 2; ++k)
#pragma unroll
                for (int br = 0; br < 3; ++br) { po[k][br] = *(const u32x4*)(PO + (size_t)br * T * AW + (size_t)(t + k) * AW + c0); pl[k][br] = PL[(size_t)br * T * NH + (size_t)(t + k) * NH + hd]; }
            u32x4 cc[4], cb[2];
#pragma unroll
            for (int j = 0; j < 4; ++j) { const bool ok = (pos + j - 2) >= 0; const size_t o = (size_t)(ok ? t + j - 2 : t) * AW + c0; cc[j] = *(const u32x4*)(CC + o); if (!ok) cc[j] = z4; }
            cb[0] = *(const u32x4*)(CB + (size_t)t * AW + c0); cb[1] = *(const u32x4*)(CB + (size_t)(t + 1) * AW + c0);
            float u[4][8];
#pragma unroll
            for (int j = 0; j < 4; ++j) unpack(cc[j], u[j]);
#pragma unroll
            for (int k = 0; k < 2; ++k) {
                float o[8], f[8];
                unpack(po[k][0], o); unpack(po[k][1], f);
#pragma unroll
                for (int e = 0; e < 8; ++e) o[e] += f[e];
                unpack(po[k][2], f);
#pragma unroll
                for (int e = 0; e < 8; ++e) o[e] += f[e];
                const float il = 1.0f / (pl[k][0] + pl[k][1] + pl[k][2]); float ss = 0.f;
#pragma unroll
                for (int e = 0; e < 8; ++e) { o[e] *= il; ss += o[e] * o[e]; }
                ss += __shfl_xor(ss, 1); ss += __shfl_xor(ss, 2); ss += __shfl_xor(ss, 4);
                float ri = 1.0f / sqrtf(ss * (1.0f / 64.f) + EPS);
                u32x4 w; w.x = cvtpk(o[0] * ri * ga[0], o[1] * ri * ga[1]); w.y = cvtpk(o[2] * ri * ga[2], o[3] * ri * ga[3]); w.z = cvtpk(o[4] * ri * ga[4], o[5] * ri * ga[5]); w.w = cvtpk(o[6] * ri * ga[6], o[7] * ri * ga[7]);
                *(u32x4*)(mix + (size_t)(t + k) * DM + c0) = w;
                float y[8], a[8];
                unpack(cb[k], a); ss = 0.f;
#pragma unroll
                for (int e = 0; e < 8; ++e) { y[e] = a[e] * (w0[e] * u[k][e] + w1[e] * u[k + 1][e] + w2[e] * u[k + 2][e]); ss += y[e] * y[e]; }
                ss += __shfl_xor(ss, 1); ss += __shfl_xor(ss, 2); ss += __shfl_xor(ss, 4);
                ri = 1.0f / sqrtf(ss * (1.0f / 64.f) + EPS);
                w.x = cvtpk(y[0] * ri * gc[0], y[1] * ri * gc[1]); w.y = cvtpk(y[2] * ri * gc[2], y[3] * ri * gc[3]); w.z = cvtpk(y[4] * ri * gc[4], y[5] * ri * gc[5]); w.w = cvtpk(y[6] * ri * gc[6], y[7] * ri * gc[7]);
                *(u32x4*)(mix + (size_t)(t + k) * DM + 512 + c0) = w;
            }
        }
    }
}
}

__device__ __forceinline__ void route_phase(const P& p, LAS unsigned char* lds, int gw, int ngw, int wave, int lane, unsigned* cnt, pg8::u32x4* rec) {
    typedef short bf16x8 __attribute__((ext_vector_type(8)));
    const bf16_t* h1b = (const bf16_t*)(p.ws + WS_H1);
    const bf16x8* WH = (const bf16x8*)(p.ws + WS_WRH); const bf16x8* WL = (const bf16x8*)(p.ws + WS_WRL);
    LAS float* sc = (LAS float*)(lds + wave * 4096);
    const int row = lane & 15, kq = lane >> 4;
    for (int tile = gw; tile < T / 16; tile += ngw) {
        const bf16_t* arow = h1b + (size_t)(tile * 16 + row) * DM + 8 * kq;
        f32x4 a0 = {0.f, 0.f, 0.f, 0.f}, a1 = {0.f, 0.f, 0.f, 0.f}; float ss = 0.f;
#pragma unroll 4
        for (int ks = 0; ks < 32; ++ks) {
            const bf16x8 a = *(const bf16x8*)(arow + 32 * ks);
            const bf16x8 bh0 = WH[(ks * 2 + 0) * 64 + lane], bh1 = WH[(ks * 2 + 1) * 64 + lane], bl0 = WL[(ks * 2 + 0) * 64 + lane], bl1 = WL[(ks * 2 + 1) * 64 + lane];
#pragma unroll
            for (int j = 0; j < 8; ++j) { const float v = bf2f((unsigned short)a[j]); ss += v * v; }
            a0 = __builtin_amdgcn_mfma_f32_16x16x32_bf16(a, bh0, a0, 0, 0, 0); a0 = __builtin_amdgcn_mfma_f32_16x16x32_bf16(a, bl0, a0, 0, 0, 0);
            a1 = __builtin_amdgcn_mfma_f32_16x16x32_bf16(a, bh1, a1, 0, 0, 0); a1 = __builtin_amdgcn_mfma_f32_16x16x32_bf16(a, bl1, a1, 0, 0, 0);
        }
        ss += __shfl_xor(ss, 16); ss += __shfl_xor(ss, 32);
        const float r = 1.0f / sqrtf(ss * (1.0f / 1024.f) + EPS);
#pragma unroll
        for (int q = 0; q < 4; ++q) { sc[(4 * kq + q) * 33 + row] = a0[q]; sc[(4 * kq + q) * 33 + 16 + row] = a1[q]; }
        asm volatile("s_waitcnt lgkmcnt(0)" ::: "memory");
        float lg[4], le[16];
#pragma unroll
        for (int e = 0; e < 4; ++e) lg[e] = sc[row * 33 + e] * r + p.b_rg[e];
#pragma unroll
        for (int e = 0; e < 16; ++e) le[e] = sc[row * 33 + 4 + e] * r + p.b_re[e];
        asm volatile("s_waitcnt lgkmcnt(0)" ::: "memory");
        int gi = 0; float gm = lg[0];
#pragma unroll
        for (int e = 1; e < 4; ++e) if (lg[e] > gm) { gm = lg[e]; gi = e; }
        float zs = 0.f;
#pragma unroll
        for (int e = 0; e < 4; ++e) zs += expf(lg[e] - gm);
        const float pg_top = 1.0f / zs;
        float l4[4];
#pragma unroll
        for (int i = 0; i < 4; ++i) l4[i] = gi == 0 ? le[i] : (gi == 1 ? le[4 + i] : (gi == 2 ? le[8 + i] : le[12 + i]));
        int i1 = 0; float m1 = l4[0];
#pragma unroll
        for (int i = 1; i < 4; ++i) if (l4[i] > m1) { m1 = l4[i]; i1 = i; }
        int i2 = -1; float m2 = -INFINITY;
#pragma unroll
        for (int i = 0; i < 4; ++i) if (i != i1 && l4[i] > m2) { m2 = l4[i]; i2 = i; }
        if (i2 < 0) i2 = (i1 + 1) & 3;
        const float t1 = 1.0f / (1.0f + expf(m2 - m1)), t2 = 1.0f - t1;
        const int a = i1 < i2 ? i1 : i2, b = i1 < i2 ? i2 : i1;
        const float ga = pg_top * (a == i1 ? t1 : t2), gb = pg_top * (b == i1 ? t1 : t2);
        const int pi = a == 0 ? b - 1 : (a == 1 ? b + 1 : 5);
        const int bucket = gi * 6 + pi;
        LAS unsigned* lcnt = (LAS unsigned*)(lds + 65536); LAS unsigned* gbase = lcnt + 32;
        if (threadIdx.x < 32) lcnt[threadIdx.x] = 0u;
        __syncthreads();
        unsigned lrank = 0u;
        if (lane < 16) lrank = __hip_atomic_fetch_add(lcnt + bucket, 1u, __ATOMIC_RELAXED, __HIP_MEMORY_SCOPE_WORKGROUP);
        __syncthreads();
        if (threadIdx.x < NBKT) { const unsigned n = lcnt[threadIdx.x]; gbase[threadIdx.x] = n ? atomicAdd(&cnt[threadIdx.x * 64], n) : 0u; }
        __syncthreads();
        if (lane < 16) { const int t = tile * 16 + row; const int pos = (int)(gbase[bucket] + lrank); rec[(size_t)bucket * T + pos] = (pg8::u32x4){(unsigned)t, __float_as_uint(r * (1.0f / (pg8::F8_SA * pg8::F8_SW1))), __float_as_uint(ga * pg8::F8_SH), __float_as_uint(gb * pg8::F8_SH)}; }
        __syncthreads();
    }
}

__global__ void __launch_bounds__(NWAVES * 64, 2) mk_fwd(P p) {
    extern __shared__ __attribute__((aligned(16))) unsigned char lds[];
    const int tid = threadIdx.x, wave = __builtin_amdgcn_readfirstlane(tid >> 6);
#define lane (opaque(tid) & 63)
    const int G = gridDim.x, gw = blockIdx.x * NWAVES + wave, ngw = G * NWAVES;
    volatile LAS unsigned* MISC = (volatile LAS unsigned*)((LAS unsigned char*)lds + MISC_OFF);
    for (int u = tid; u < 32; u += NWAVES * 64) MISC[u] = 0u;
    __syncthreads();
    XcdBarrier bar = xcd_barrier_post((unsigned*)(p.ws + WS_CTL) + CW_BAR, MISC + 8);
#define GRID_BAR() xcd_barrier(bar)
    LAS unsigned char* L = (LAS unsigned char*)lds;
#ifndef PROBE_DUP
#define PROBE_DUP 0
#endif
#define REP(k) for (int rep_ = 0; rep_ < ((PROBE_DUP == (k)) ? 3 : 1); ++rep_)
    REP(1) { p0_prologue(p, L, gw, ngw, wave, lane);
    GRID_BAR(); }
    REP(2) { { pg8::DenseSched<DM, DM> S; S.init(T, NZ, G, (int)blockIdx.x); S.A = (const char*)(p.ws + WS_XB); S.Bt = (const char*)(p.ws + WS_WIN);
      pg8::EpiZ E{p.ws, p.q_norm, p.k_norm, (const float*)(p.ws + WS_RINVX)};
      pg8::gemm_phase(L, L + STASH_OFF, S, E); }
    GRID_BAR(); }
    REP(3) { att::attn_phase<0>(p, L, gw, ngw, wave, lane);
      p0_weights(p, L, gw, ngw, wave, lane, 1); p0_weights(p, L, gw, ngw, wave, lane, 2); p0_late(p, gw, ngw, lane);
    GRID_BAR(); }
    REP(4) { att::mix_phase(p, gw, ngw, lane);
    GRID_BAR(); }
    REP(5) { { pg8::DenseSched<DM, DM> S; S.init(T, DM, G, (int)blockIdx.x); S.A = (const char*)(p.ws + WS_XN); S.Bt = (const char*)(p.ws + WS_WOUT);
      pg8::EpiO E{(const bf16_t*)(p.ws + WS_XB), (bf16_t*)(p.ws + WS_H1), p.ws + WS_H1F8};
      pg8::gemm_phase(L, L + STASH_OFF, S, E); }
    GRID_BAR(); }
    REP(6) { const bool real = (rep_ == ((PROBE_DUP == 6) ? 2 : 0));
      route_phase(p, L, gw, ngw, wave, lane, (unsigned*)(p.ws + WS_CTL) + (real ? CW_CNT : 16384 + 2048 * rep_), real ? (pg8::u32x4*)(p.ws + WS_REC) : (pg8::u32x4*)(p.ws + WS_PO));
    GRID_BAR(); }
    int total_sr;
    { const unsigned* cnt = (const unsigned*)(p.ws + WS_CTL) + CW_CNT; LAS int* tt = (LAS int*)(L + TT_OFF);
      LAS int* rk = (LAS int*)(L + TT_OFF + MAXTILES * 16);
      if (tid < NBKT) { const int rb = (int)cnt[tid * 64] & 255; int rank = 0;
        for (int b2 = 0; b2 < NBKT; ++b2) { const int r2 = (int)cnt[b2 * 64] & 255; rank += (r2 > rb || (r2 == rb && b2 < tid)) ? 1 : 0; }
        rk[tid] = rb > 0 ? rank : -1; }
      __syncthreads();
      int o_ = 0, R_ = 0, b_ = -1, off_ = 0;
      for (int b2 = 0; b2 < NBKT; ++b2) { const int n = (int)cnt[b2 * 64], nf = n >> 8; if (tid >= o_ && tid < o_ + nf) { b_ = b2; off_ = (tid - o_) * 256; } o_ += nf; R_ += (n & 255) ? 1 : 0; }
      if (tid >= o_ && tid < o_ + R_) { const int r = tid - o_; for (int b2 = 0; b2 < NBKT; ++b2) if (rk[b2] == r) { b_ = b2; off_ = ((int)cnt[b2 * 64] >> 8) * 256; } }
      total_sr = (o_ + R_) * 256;
      if (tid < MAXTILES) { const bool ok_ = b_ >= 0; if (!ok_) { b_ = 0; off_ = 0; } tt[tid * 4] = b_; tt[tid * 4 + 1] = tid * 256 - off_; tt[tid * 4 + 2] = ok_ ? (int)cnt[b_ * 64] : 0; tt[tid * 4 + 3] = 0; }
      __syncthreads(); }
    REP(8) { { pg8::Moe1Sched S; S.init(total_sr, 2048, G, (int)blockIdx.x); S.tail_split(); S.h1b = (const char*)(p.ws + WS_H1F8); S.W13 = (const char*)(p.ws + WS_W13); S.list = (const int*)(p.ws + WS_REC); S.tt = (const LAS int*)(L + TT_OFF);
      pg8::EpiM1 E{p.ws + WS_H, (const pg8::u32x4*)(p.ws + WS_REC)};
      pg8::gemm_phase(L, L + STASH_OFF, S, E); }
      { const int n1 = (total_sr / 256) * 8, r1 = n1 % G, ne1 = G - r1, c = (int)blockIdx.x; int u1 = 2 * ne1; if (u1 > 512) u1 = 512;
        pg8::UOrder S; S.A = (const char*)(p.ws + WS_PB); S.Bt = (const char*)(p.ws + WS_WP); S.first = c - r1; S.stride = ne1; S.count = (c >= r1) ? ((c - r1 + ne1 < u1) ? 2 : ((c - r1 < u1) ? 1 : 0)) : 0;
        pg8::EpiU E{(bf16_t*)(p.ws + WS_U), (float*)(p.ws + WS_SSQU), p.g_ple_post};
        pg8::gemm_phase(L, L + STASH_OFF, S, E); }
    GRID_BAR(); }
    REP(9) { { pg8::Moe2Sched S; S.init(total_sr, DM, G, (int)blockIdx.x); S.tail_split(); S.H = (const char*)(p.ws + WS_H); S.W2 = (const char*)(p.ws + WS_W2); S.tt = (const LAS int*)(L + TT_OFF);
      pg8::EpiM2 E{(const bf16_t*)(p.ws + WS_H1), (bf16_t*)(p.ws + WS_XN), (float*)(p.ws + WS_SSQ2), (const int*)(p.ws + WS_REC), p.ws + WS_H2F8};
      pg8::gemm_phase(L, L + STASH_OFF, S, E); }
      { const int nt_ = total_sr / 256, n1 = nt_ * 8, r1 = n1 % G, ne1 = G - r1; int u1 = 2 * ne1; if (u1 > 512) u1 = 512;
        const int n2 = nt_ * 4, r2 = n2 % G, ne2 = G - r2, c = (int)blockIdx.x, rem = 512 - u1;
        pg8::UOrder S; S.A = (const char*)(p.ws + WS_PB); S.Bt = (const char*)(p.ws + WS_WP); S.first = u1 + (c - r2); S.stride = ne2; S.count = (c >= r2 && c - r2 < rem) ? (rem - (c - r2) + ne2 - 1) / ne2 : 0;
        pg8::EpiU E{(bf16_t*)(p.ws + WS_U), (float*)(p.ws + WS_SSQU), p.g_ple_post};
        pg8::gemm_phase(L, L + STASH_OFF, S, E); }
    GRID_BAR(); }
    REP(10) { { pg8::DenseSched<DM, DM, 1> S; S.init(T, DM, G, (int)blockIdx.x); S.A = (const char*)(p.ws + WS_H2F8); S.Bt = (const char*)(p.ws + WS_WG);
      pg8::EpiG E{p.out, (const bf16_t*)(p.ws + WS_XN), (const bf16_t*)(p.ws + WS_U), (const float*)(p.ws + WS_SSQ2), (const float*)(p.ws + WS_SSQU)};
      pg8::gemm_phase(L, L + STASH_OFF, S, E); }
      if (rep_ + 1 < ((PROBE_DUP == 10) ? 3 : 1)) GRID_BAR(); }
}

extern "C" void kernel_launch(void* const* d_in, const int* in_sizes, int n_in, void* d_out, int out_size, void* d_ws, size_t ws_size, hipStream_t stream) {
    static int grid = 0;
    if (grid == 0) {
        int dev = 0, cus = 0, per_cu = 0;
        if (n_in != 22 || out_size != T * DM || ws_size < WS_END) { fprintf(stderr, "kernel_launch: unexpected problem shape / workspace\n"); grid = -1; return; }
        (void)hipGetDevice(&dev);
        (void)hipDeviceGetAttribute(&cus, hipDeviceAttributeMultiprocessorCount, dev);
        (void)hipFuncSetAttribute((const void*)mk_fwd, hipFuncAttributeMaxDynamicSharedMemorySize, LDS_BYTES);
        (void)hipOccupancyMaxActiveBlocksPerMultiprocessor(&per_cu, (const void*)mk_fwd, NWAVES * 64, LDS_BYTES);
        (void)hipGetLastError();
        if (per_cu < 1) { fprintf(stderr, "kernel_launch: occupancy query says %d blocks/CU\n", per_cu); grid = -1; return; }
        grid = cus;
    }
    if (grid < 0) return;
    P p{};
    const float* const* in = (const float* const*)d_in;
    p.x = in[0]; p.p = in[1]; p.g_mix = in[2]; p.w_in = in[3]; p.q_norm = in[4]; p.k_norm = in[5]; p.conv_w = in[6]; p.g_attn_out = in[7]; p.g_conv_out = in[8];
    p.w_out = in[9]; p.g_ffn = in[10]; p.w_rg = in[11]; p.b_rg = in[12]; p.w_re = in[13]; p.b_re = in[14]; p.w1 = in[15]; p.w3 = in[16]; p.w2 = in[17];
    p.g_ple = in[18]; p.w_ple_gate = in[19]; p.w_ple_proj = in[20]; p.g_ple_post = in[21];
    p.out = (float*)d_out; p.ws = (unsigned char*)d_ws;
    for (int i = 0; i < 8; ++i) p.inv_freq[i] = (float)pow(500000.0, -(double)(2 * i) / 16.0);
    (void)hipMemsetAsync((char*)d_ws + WS_CTL, 0, CTL_ZERO_BYTES, stream);
    void* args[] = {&p};
    hipError_t e = hipLaunchCooperativeKernel((const void*)mk_fwd, dim3(grid), dim3(NWAVES * 64), args, LDS_BYTES, stream);
    if (e != hipSuccess) fprintf(stderr, "cooperative launch failed: %s (grid %d)\n", hipGetErrorString(e), grid);
}
```

```cpp
#include <hip/hip_runtime.h>
#include <stdint.h>
#include <math.h>
#include <stdio.h>

typedef float f32x16 __attribute__((ext_vector_type(16)));
typedef float f32x4 __attribute__((ext_vector_type(4)));
typedef unsigned short bf16_t;
#define LAS __attribute__((address_space(3)))

constexpr int T = 32768, DM = 1024, SEQ = 8192, NZ = 3072, NH = 8, HD = 64, PLE = 256, FF = 512, AW = 512;
constexpr int PAD = 256;
constexpr int NBKT = 24;
constexpr int MAXTILES = (T + NBKT * 256) / 256;
constexpr float EPS = 1e-6f;
constexpr size_t MiB = 1u << 20;
constexpr int NWAVES = 8;
constexpr int LDS_BYTES = 163840;
constexpr int OUTT_OFF = 147456;
constexpr int MISC_OFF = 131072 + 320, TT_OFF = 131072 + 1024, STASH_OFF = 135168;

constexpr size_t WS_CTL = 0, CTL_ZERO_BYTES = 1 * MiB;
constexpr int CW_BAR = 4096, CW_CNT = 1024;
constexpr size_t WS_LIST = 1 * MiB, WS_TOKGA = 4 * MiB, WS_TOKGB = WS_TOKGA + 256 * 1024, WS_RINV1 = WS_TOKGB + 256 * 1024, WS_RINVX = WS_RINV1 + 256 * 1024;
constexpr size_t WS_ROPE = 6 * MiB + 512 * 1024;
constexpr size_t WS_WRH = 7 * MiB, WS_WRL = WS_WRH + 64 * 1024;
constexpr size_t WS_SSQU = 8 * MiB, WS_SSQ2 = 10 * MiB;
constexpr size_t WS_WIN = 16 * MiB, WS_WOUT = 22 * MiB, WS_W13 = 24 * MiB, WS_W2 = 56 * MiB, WS_WG = 72 * MiB, WS_WP = 74 * MiB;
constexpr size_t WS_XN = 80 * MiB;
constexpr size_t WS_REC = 304 * MiB;
constexpr size_t WS_Q = 144 * MiB, WS_K = 176 * MiB, WS_V = 208 * MiB, WS_CB = 240 * MiB, WS_CC = 272 * MiB, WS_CH = 304 * MiB;
constexpr size_t WS_H2F8 = 208 * MiB;
constexpr size_t WS_H1F8 = 208 * MiB;
constexpr size_t WS_H1 = 144 * MiB;
constexpr size_t WS_U = 336 * MiB;
constexpr size_t WS_XB = 336 * MiB;
constexpr size_t WS_PB = 496 * MiB;
constexpr size_t WS_PO = 400 * MiB, WS_PL = 12 * MiB;
constexpr size_t WS_H = 400 * MiB;
constexpr size_t WS_END = 512 * MiB;

struct P {
    const float *x, *p, *g_mix, *w_in, *q_norm, *k_norm, *conv_w, *g_attn_out, *g_conv_out, *w_out, *g_ffn, *w_rg, *b_rg, *w_re, *b_re,
        *w1, *w3, *w2, *g_ple, *w_ple_gate, *w_ple_proj, *g_ple_post;
    float* out;
    unsigned char* ws;
    float inv_freq[8];
};

__device__ __forceinline__ int opaque(int x) { asm volatile("" : "+v"(x)); return x; }
__device__ __forceinline__ float bf2f(unsigned b) { return __uint_as_float(b << 16); }
__device__ __forceinline__ unsigned f2bf(float f) { unsigned u = __float_as_uint(f); return (u + 0x7fffu + ((u >> 16) & 1u)) >> 16; }
__device__ __forceinline__ void bucket_of(const unsigned* cnt, int sr, int& bsel, int& base, int& total) {
    int o = 0; bsel = -1; base = 0;
#pragma unroll
    for (int b = 0; b < NBKT; ++b) { const int n = (int)cnt[b * 64], np = (n + PAD - 1) / PAD * PAD; if (sr >= o && sr < o + np) { bsel = b; base = o; } o += np; }
    total = o;
}
__device__ __forceinline__ void bucket_experts(int b, int& ea, int& eb) {
    const int g = b / 6, pi = b % 6;
    const int a = pi < 3 ? 0 : (pi < 5 ? 1 : 2);
    const int bb = pi < 3 ? pi + 1 : (pi < 5 ? pi - 1 : 3);
    ea = g * 4 + a; eb = g * 4 + bb;
}

#define XB_TMO      128
#define XB_XCNT(j)  (256  + 64 * (j))
#define XB_XSUB(j)  (1280 + 64 * (j))
#define XB_XGEN(j)  (2304 + 64 * (j))
#define XB_TOP      3328
#define XB_TOPGEN   3392
#define XCD_BAR_WORDS 3456
#define XB_SPIN_CAP (1u << 22)
__device__ __forceinline__ unsigned xb_ld(unsigned* p)              { return __hip_atomic_load(p, __ATOMIC_RELAXED, __HIP_MEMORY_SCOPE_AGENT); }
__device__ __forceinline__ unsigned xb_add(unsigned* p, unsigned v) { return __hip_atomic_fetch_add(p, v, __ATOMIC_RELAXED, __HIP_MEMORY_SCOPE_AGENT); }
__device__ __forceinline__ unsigned xb_xcc_id() { return (unsigned)__builtin_amdgcn_s_getreg((3 << 11) | 20) & 0xFu; }
#define XB_SPIN(cond, bar) do { unsigned _sp = 0; while (cond) { __builtin_amdgcn_s_sleep(1); \
    if ((++_sp & 255u) == 0u) { if (xb_ld(&(bar)[XB_TMO])) break; if (_sp > XB_SPIN_CAP) { atomicAdd(&(bar)[XB_TMO], 1u); break; } } } } while (0)
struct XcdBarrier { unsigned* bar; unsigned x; volatile LAS unsigned* st; };
__device__ __forceinline__ XcdBarrier xcd_barrier_post(unsigned* bar, volatile LAS unsigned* st) {
    XcdBarrier b; b.bar = bar; b.x = xb_xcc_id(); b.st = st;
    if (threadIdx.x == 0) (void)xb_add(&bar[XB_XCNT(b.x)], 1u);
    return b;
}
__device__ __forceinline__ void xcd_barrier_complete(unsigned* bar, unsigned x, unsigned& nloc, unsigned& nx) {
    const unsigned G = gridDim.x * gridDim.y * gridDim.z;
    unsigned sum, cnt, mine, sp = 0u;
    for (;;) {
        sum = 0u; cnt = 0u; mine = 0u;
#pragma unroll
        for (unsigned j = 0; j < 16; ++j) { const unsigned c = xb_ld(&bar[XB_XCNT(j)]); sum += c; cnt += (c > 0u) ? 1u : 0u; mine = (j == x) ? c : mine; }
        if (sum == G) break;
        __builtin_amdgcn_s_sleep(1);
        if ((++sp & 255u) == 0u) { if (xb_ld(&bar[XB_TMO])) break; if (sp > XB_SPIN_CAP) { atomicAdd(&bar[XB_TMO], 1u); break; } }
    }
    nloc = mine > 0u ? mine : 1u; nx = cnt > 0u ? cnt : 1u;
}
__device__ __forceinline__ void xcd_arrive(const XcdBarrier& b) {
    asm volatile("s_waitcnt vmcnt(0)" ::: "memory");
    __syncthreads();
    if (threadIdx.x == 0) {
        unsigned* bar = b.bar;
        __builtin_amdgcn_s_waitcnt(0);
        unsigned nloc = b.st[0], nx = b.st[1];
        if (nloc == 0u) { xcd_barrier_complete(bar, b.x, nloc, nx); b.st[0] = nloc; b.st[1] = nx; }
        const unsigned old = xb_add(&bar[XB_XSUB(b.x)], 1u);
        const unsigned gen = old / nloc; b.st[2] = gen;
        if (old + 1u == (gen + 1u) * nloc) {
            __builtin_amdgcn_fence(__ATOMIC_RELEASE, "agent");
            asm volatile("s_waitcnt vmcnt(0)" ::: "memory");
            const unsigned og = xb_add(&bar[XB_TOP], 1u);
            const unsigned tg = og / nx;
            if (og + 1u == (tg + 1u) * nx) {
#pragma unroll
                for (unsigned j = 0; j < 16; ++j) (void)xb_add(&bar[XB_XGEN(j)], 1u);
            }
        }
    }
}
__device__ __forceinline__ void xcd_wait(const XcdBarrier& b) {
    if (threadIdx.x == 0) {
        unsigned* bar = b.bar; const unsigned gen = b.st[2];
        XB_SPIN(xb_ld(&bar[XB_XGEN(b.x)]) == gen, bar);
        __builtin_amdgcn_fence(__ATOMIC_ACQUIRE, "agent");
        asm volatile("s_waitcnt vmcnt(0)" ::: "memory");
    }
    __syncthreads();
}
__device__ __forceinline__ void xcd_barrier(const XcdBarrier& b) { xcd_arrive(b); xcd_wait(b); }

namespace pg8 {
typedef short bf16x8 __attribute__((ext_vector_type(8)));
typedef unsigned u32x4 __attribute__((ext_vector_type(4)));
typedef unsigned u32x2 __attribute__((ext_vector_type(2)));
constexpr int BM = 256, BK = 64, HALF = 128, HTB = HALF * BK * 2, STAGE_BYTES = 8 * HTB, NXCD = 8, WGM = 8;
__host__ __device__ __forceinline__ int lds_byte(int r, int c) { const int st = (r >> 4) * 2 + (c >> 5), rr = r & 15, cc = c & 31, ob = rr * 64 + cc * 2; return st * 1024 + (ob ^ (((ob >> 9) & 1) << 5)); }
__host__ __device__ __forceinline__ void stage_rc(int b, int& R, int& C) { const int st = b / 1024, sb = b % 1024, swz = sb ^ (((sb >> 9) & 1) << 5); R = (st >> 1) * 16 + swz / 64; C = (st & 1) * 32 + (swz % 64) / 2; }
struct Unit { int pm, pn, ea, eb, b, base, cnt; };
struct StaticOrder {
    int nM, nN, nwg, G, c, split;
    __device__ __forceinline__ void init(int M, int N, int G_, int c_) { nM = M / BM; nN = N / BM; nwg = nM * nN; G = G_; c = c_; split = 0; }
    __device__ __forceinline__ void tail_split() { const int s_ = (nwg / G) * G; split = (s_ > 0 && s_ < nwg && s_ % nN == 0) ? s_ : 0; }
    __device__ __forceinline__ bool next(int i, Unit& u) const {
        const long L = (long)i * G + c; if (L >= nwg) return false;
        int wgid = (int)L; u.ea = 0; u.eb = 0; u.b = 0; u.base = 0; u.cnt = 0;
        if (split > 0 && wgid >= split) { u.pm = wgid / nN; u.pn = wgid % nN; return true; }
        const int nwge = split > 0 ? split : nwg, nMe = split > 0 ? split / nN : nM;
        { const int q = nwge / NXCD, r = nwge % NXCD, xcd = wgid % NXCD, off = wgid / NXCD; wgid = (xcd < r ? xcd * (q + 1) : r * (q + 1) + (xcd - r) * q) + off; }
        const int nig = WGM * nN, gid = wgid / nig, fm = gid * WGM, gsz = (nMe - fm) < WGM ? (nMe - fm) : WGM;
        u.pm = fm + ((wgid % nig) % gsz); u.pn = (wgid % nig) / gsz; return true;
    }
};
typedef int v4i_t __attribute__((ext_vector_type(4))); typedef int v8i_t __attribute__((ext_vector_type(8))); typedef float f32x2_t __attribute__((ext_vector_type(2)));
__device__ __forceinline__ v8i_t ld8(const LAS unsigned char* p0, const LAS unsigned char* p1) { const v4i_t l = *(const LAS v4i_t*)p0, h = *(const LAS v4i_t*)p1; return __builtin_shufflevector(l, h, 0, 1, 2, 3, 4, 5, 6, 7); }
__device__ __forceinline__ unsigned pk4_fp8(float a, float b, float c, float d) {
    a = __builtin_amdgcn_fmed3f(a, -448.f, 448.f); b = __builtin_amdgcn_fmed3f(b, -448.f, 448.f); c = __builtin_amdgcn_fmed3f(c, -448.f, 448.f); d = __builtin_amdgcn_fmed3f(d, -448.f, 448.f);
    unsigned w = 0; w = __builtin_amdgcn_cvt_pk_fp8_f32(a, b, w, false); w = __builtin_amdgcn_cvt_pk_fp8_f32(c, d, w, true); return w; }
constexpr float F8_SA = 8.f, F8_SW1 = 128.f, F8_SH = 32.f, F8_SW2 = 64.f, F8_SA2 = 8.f, F8_SWG = 128.f, F8_SU = 16.f, F8_SPB = 16.f, F8_SWP = 128.f;
__device__ __forceinline__ unsigned cvt_pk_bf16(float lo, float hi) { unsigned r; asm volatile("v_cvt_pk_bf16_f32 %0, %1, %2" : "=v"(r) : "v"(lo), "v"(hi)); return r; }

template <class Epi, class Sched>
__device__ __forceinline__ void gemm_phase(LAS unsigned char* lds, LAS unsigned char* stash, const Sched& S, const Epi& E) {
    const int tid = opaque((int)threadIdx.x), wid = __builtin_amdgcn_readfirstlane(tid >> 6), lane = tid & 63, wr = wid >> 2, wc = wid & 3, fr = lane & 15, fq = lane >> 4;
    constexpr int K = Sched::K, EB = Sched::EB, nt = K * EB / 128;
    constexpr bool GA = Sched::GATHER, F8 = (EB == 1);
    static_assert((K * EB) % 256 == 0 && K * EB >= 256, "K");
    unsigned voffB[2], voffA[2];
#pragma unroll
    for (int i = 0; i < 2; ++i) { int R, C; stage_rc(tid * 16 + i * 8192, R, C); voffB[i] = (unsigned)(R * Sched::LDB * EB + C * 2); voffA[i] = (unsigned)(R * Sched::LDA * EB + C * 2); }
    constexpr size_t kstep = (size_t)(BK * 2);
    constexpr size_t hstepB = (size_t)HALF * Sched::LDB * EB, hstepA = (size_t)HALF * Sched::LDA * EB;
    const unsigned ldsw = (unsigned)wid * 1024u;
    const int aoff = F8 ? lds_byte(wr * 64 + fr, 16 * fq) : lds_byte(wr * 64 + fr, fq * 8), boff = F8 ? lds_byte(wc * 32 + fr, 16 * fq) : lds_byte(wc * 32 + fr, fq * 8);
    const int aoff1 = F8 ? lds_byte(wr * 64 + fr, 16 * fq + 8) : aoff + 1024, boff1 = F8 ? lds_byte(wc * 32 + fr, 16 * fq + 8) : boff + 1024;
#define PG8_SA(b, h) (((b) * 2 + (h)) * HTB)
#define PG8_SB(b, h) ((4 + (b) * 2 + (h)) * HTB)
#define PG8_STAGE2(bufoff, gbase, o0, o1) do { \
        __builtin_amdgcn_global_load_lds((const unsigned*)((const char*)(gbase) + (o0)), (LAS unsigned*)(lds + (bufoff) + ldsw), 16, 0, 0); \
        __builtin_amdgcn_global_load_lds((const unsigned*)((const char*)(gbase) + (o1)), (LAS unsigned*)(lds + (bufoff) + ldsw + 8192), 16, 0, 0); } while (0)
#define PG8_STAGEB(bufoff, gbase) PG8_STAGE2(bufoff, gbase, voffB[0], voffB[1])
#define PG8_STAGEA(bufoff, koff, h, NX) do { if constexpr (GA) { if (NX) PG8_STAGE2(bufoff, aB + (koff), xg[h][0], xg[h][1]); else PG8_STAGE2(bufoff, aB + (koff), voG[h][0], voG[h][1]); } \
        else PG8_STAGE2(bufoff, ((NX) ? nA : cA) + (h) * hstepA + (koff), voffA[0], voffA[1]); } while (0)
#define PG8_LDA(dst, b, h) do { if constexpr (F8) { _Pragma("unroll") for (int m = 0; m < 4; ++m) dst##8[m] = ld8(lds + PG8_SA(b, h) + aoff + m * 2048, lds + PG8_SA(b, h) + aoff1 + m * 2048); } \
        else { _Pragma("unroll") for (int m = 0; m < 4; ++m) _Pragma("unroll") for (int k = 0; k < 2; ++k) dst[m][k] = *(const LAS bf16x8*)(lds + PG8_SA(b, h) + (k ? aoff1 : aoff) + m * 2048); } } while (0)
#define PG8_LDB(dst, b, h) do { if constexpr (F8) { _Pragma("unroll") for (int n = 0; n < 2; ++n) dst##8[n] = ld8(lds + PG8_SB(b, h) + boff + n * 2048, lds + PG8_SB(b, h) + boff1 + n * 2048); } \
        else { _Pragma("unroll") for (int n = 0; n < 2; ++n) _Pragma("unroll") for (int k = 0; k < 2; ++k) dst[n][k] = *(const LAS bf16x8*)(lds + PG8_SB(b, h) + (k ? boff1 : boff) + n * 2048); } } while (0)
#define PG8_MMA(ai, bj, At, Bt) do { __builtin_amdgcn_s_setprio(1); \
        if constexpr (F8) { _Pragma("unroll") for (int m = 0; m < 4; ++m) _Pragma("unroll") for (int n = 0; n < 2; ++n) \
            asm volatile("v_mfma_scale_f32_16x16x128_f8f6f4 %0, %1, %2, %0, %3, %3 op_sel_hi:[0,0,0]" : "+v"(acc[ai][bj][m][n]) : "v"(Bt##8[n]), "v"(At##8[m]), "v"(f8one)); } \
        else { _Pragma("unroll") for (int m = 0; m < 4; ++m) _Pragma("unroll") for (int n = 0; n < 2; ++n) _Pragma("unroll") for (int k = 0; k < 2; ++k) \
            acc[ai][bj][m][n] = __builtin_amdgcn_mfma_f32_16x16x32_bf16(Bt[n][k], At[m][k], acc[ai][bj][m][n], 0, 0, 0); } \
        __builtin_amdgcn_s_setprio(0); } while (0)
#define PG8_WAIT_V(n) asm volatile("s_waitcnt vmcnt(" #n ")" ::: "memory")
#define PG8_WAIT_L(n) asm volatile("s_waitcnt lgkmcnt(" #n ")" ::: "memory")
#define PG8_BAR __builtin_amdgcn_s_barrier()
#define PG8_SCHED __builtin_amdgcn_sched_barrier(0)
    Unit cur, nxt; int ui = 0;
    if (!S.next(0, cur)) return;
    f32x4 acc[2][2][4][2];
#pragma unroll
    for (int a = 0; a < 2; ++a)
#pragma unroll
        for (int b = 0; b < 2; ++b)
#pragma unroll
            for (int m = 0; m < 4; ++m)
#pragma unroll
                for (int n = 0; n < 2; ++n) acc[a][b][m][n] = (f32x4){0.f, 0.f, 0.f, 0.f};
    const int f8one = 0x7F7F7F7F;
    bf16x8 At[4][2], B0[2][2], B1[2][2];
    v8i_t At8[4], B08[2], B18[2];
    unsigned voG[2][2] = {{0u, 0u}, {0u, 0u}}, xg[2][2] = {{0u, 0u}, {0u, 0u}};
    const char* aB = nullptr; const char* cA = nullptr; const char* nA = nullptr;
    if constexpr (GA) { aB = S.a_base(); S.a_goffs(cur, tid, voG); } else { cA = S.a_ptr(cur); }
    LAS u32x4* const mystash = (LAS u32x4*)stash + tid;
    { const char* cB0 = S.b_ptr(cur, 0); const char* cB1 = S.b_ptr(cur, 1);
      PG8_STAGEB(PG8_SB(0, 0), cB0); PG8_STAGEB(PG8_SB(0, 1), cB0 + hstepB); PG8_STAGEA(PG8_SA(0, 0), 0, 0, false); PG8_STAGEA(PG8_SA(0, 1), 0, 1, false);
      if (wr == 1) PG8_BAR;
      PG8_WAIT_V(2); PG8_BAR;
      PG8_STAGEB(PG8_SB(1, 0), cB1); PG8_STAGEA(PG8_SA(1, 0), kstep, 0, false); PG8_STAGEB(PG8_SB(1, 1), cB1 + hstepB);
      PG8_WAIT_V(6); PG8_BAR; }
    for (;;) {
        const bool has_next = S.next(ui + 1, nxt);
        Unit un; un.pm = has_next ? nxt.pm : cur.pm; un.pn = has_next ? nxt.pn : cur.pn; un.ea = has_next ? nxt.ea : cur.ea; un.eb = has_next ? nxt.eb : cur.eb; un.b = has_next ? nxt.b : cur.b; un.base = has_next ? nxt.base : cur.base; un.cnt = has_next ? nxt.cnt : cur.cnt;
        if constexpr (GA) { unsigned vn[2][2]; S.a_goffs(un, tid, vn); *mystash = (u32x4){vn[0][0], vn[0][1], vn[1][0], vn[1][1]}; }
        else nA = S.a_ptr(un);
#pragma unroll 1
        for (int t = 0; t < nt; t += 2) {
            const bool last = (t == nt - 2);
            const char* b2 = last ? S.b_ptr(un, 0) : S.b_ptr(cur, t + 2);
            const char* b3 = last ? S.b_ptr(un, 1) : S.b_ptr(cur, t + 3);
            const size_t k1 = (size_t)(t + 1) * kstep, k2 = last ? 0 : (size_t)(t + 2) * kstep, k3 = k2 + kstep;
            if constexpr (GA) { if (last) { const u32x4 q = *mystash; xg[0][0] = q.x; xg[0][1] = q.y; xg[1][0] = q.z; xg[1][1] = q.w; } }
            PG8_LDB(B0, 0, 0); PG8_LDB(B1, 0, 1); PG8_SCHED; PG8_LDA(At, 0, 0); PG8_STAGEA(PG8_SA(1, 1), k1, 1, false);
            PG8_WAIT_V(8); PG8_WAIT_L(0); PG8_BAR; PG8_MMA(0, 0, At, B0); PG8_MMA(0, 1, At, B1); PG8_BAR; PG8_SCHED;
            PG8_LDA(At, 0, 1); PG8_STAGEB(PG8_SB(0, 0), b2); PG8_STAGEB(PG8_SB(0, 1), b2 + hstepB); PG8_STAGEA(PG8_SA(0, 0), k2, 0, last);
            PG8_WAIT_V(8); PG8_WAIT_L(0); PG8_BAR; PG8_MMA(1, 0, At, B0); PG8_MMA(1, 1, At, B1); PG8_BAR; PG8_SCHED;
            PG8_LDB(B0, 1, 0); PG8_LDB(B1, 1, 1); PG8_SCHED; PG8_LDA(At, 1, 0); PG8_STAGEA(PG8_SA(0, 1), k2, 1, last);
            PG8_WAIT_V(8); PG8_WAIT_L(0); PG8_BAR; PG8_MMA(0, 0, At, B0); PG8_MMA(0, 1, At, B1); PG8_BAR; PG8_SCHED;
            PG8_LDA(At, 1, 1); PG8_STAGEB(PG8_SB(1, 0), b3); PG8_STAGEB(PG8_SB(1, 1), b3 + hstepB); PG8_STAGEA(PG8_SA(1, 0), k3, 0, last);
            PG8_WAIT_V(8); PG8_WAIT_L(0); PG8_BAR; PG8_MMA(1, 0, At, B0); PG8_MMA(1, 1, At, B1); PG8_BAR; PG8_SCHED;
        }
        if (wr == 0) PG8_BAR;
        E(acc, cur, wr, wc, fr, fq);
        if (!has_next) break;
#pragma unroll
        for (int a = 0; a < 2; ++a)
#pragma unroll
            for (int b = 0; b < 2; ++b)
#pragma unroll
                for (int m = 0; m < 4; ++m)
#pragma unroll
                    for (int n = 0; n < 2; ++n) acc[a][b][m][n] = (f32x4){0.f, 0.f, 0.f, 0.f};
        cur = nxt; ++ui;
        if constexpr (GA) { const u32x4 q = *mystash; voG[0][0] = q.x; voG[0][1] = q.y; voG[1][0] = q.z; voG[1][1] = q.w; } else cA = nA;
        if (wr == 1) PG8_BAR;
    }
    PG8_WAIT_V(0);
    PG8_BAR;
#undef PG8_SA
#undef PG8_SB
#undef PG8_STAGE2
#undef PG8_STAGEB
#undef PG8_STAGEA
#undef PG8_LDA
#undef PG8_LDB
#undef PG8_MMA
#undef PG8_WAIT_V
#undef PG8_WAIT_L
#undef PG8_BAR
#undef PG8_SCHED
}

template <int K_, int LDA_, int EB_ = 2> struct DenseSched : StaticOrder {
    static constexpr int K = K_, LDB = K_, LDA = LDA_, EB = EB_; static constexpr bool GATHER = false;
    const char* A; const char* Bt;
    __device__ __forceinline__ const char* a_ptr(const Unit& u) const { return A + (size_t)u.pm * BM * LDA_ * EB_; }
    __device__ __forceinline__ const char* b_ptr(const Unit& u, int t) const { return Bt + (size_t)u.pn * BM * K_ * EB_ + (size_t)t * 128; }
};
struct UOrder {
    static constexpr int K = PLE, LDB = PLE, LDB2 = PLE, LDA = PLE, EB = 1; static constexpr bool GATHER = false;
    const char* A; const char* Bt; int first, stride, count;
    __device__ __forceinline__ void a_ready(const Unit&, int) const {}
    __device__ __forceinline__ void done(const Unit&, int) const {}
    __device__ __forceinline__ bool alt(const Unit&) const { return false; }
    __device__ __forceinline__ bool next(int i, Unit& u) const { if (i >= count) return false; const int L = first + i * stride; u.pm = L >> 2; u.pn = L & 3; u.ea = 0; u.eb = 0; u.b = 0; u.base = 0; u.cnt = 0; return true; }
    __device__ __forceinline__ const char* a_ptr(const Unit& u) const { return A + (size_t)u.pm * BM * PLE; }
    __device__ __forceinline__ const char* b_ptr(const Unit& u, int t) const { return Bt + (size_t)u.pn * BM * PLE + (size_t)t * 128; }
};
__device__ __forceinline__ void tile_info(const LAS int* tt, Unit& u) {
    const int b = __builtin_amdgcn_readfirstlane(tt[u.pm * 4]), base = __builtin_amdgcn_readfirstlane(tt[u.pm * 4 + 1]), cnt = __builtin_amdgcn_readfirstlane(tt[u.pm * 4 + 2]);
    u.b = b; u.base = base; u.cnt = cnt; bucket_experts(b, u.ea, u.eb);
}
struct Moe1Sched : StaticOrder {
    static constexpr int K = DM, LDA = DM, LDB = DM, EB = 1; static constexpr bool GATHER = true;
    const char* h1b; const char* W13; const int* list; const LAS int* tt;
    __device__ __forceinline__ bool next(int i, Unit& u) const { if (!StaticOrder::next(i, u)) return false; tile_info(tt, u); return true; }
    __device__ __forceinline__ const char* a_base() const { return h1b; }
    __device__ __forceinline__ void a_goffs(const Unit& u, int tid, unsigned (&vo)[2][2]) const {
#pragma unroll
        for (int i = 0; i < 2; ++i) { int R, C; stage_rc(tid * 16 + i * 8192, R, C);
#pragma unroll
            for (int h = 0; h < 2; ++h) { const int pos = u.pm * BM - u.base + h * HALF + R; const int tok = pos < u.cnt ? list[((size_t)u.b * T + pos) * 4] : 0; vo[h][i] = (unsigned)(tok * DM + C * 2); } }
    }
    __device__ __forceinline__ const char* b_ptr(const Unit& u, int t) const { const int e = u.pn < 4 ? u.ea : u.eb; return W13 + (size_t)e * (1024 * 1024) + (size_t)(u.pn & 3) * (BM * DM) + (size_t)t * 128; }
};
struct Moe2Sched : StaticOrder {
    static constexpr int K = 1024, LDA = 1024, LDB = FF, EB = 1; static constexpr bool GATHER = false;
    const char* H; const char* W2; const LAS int* tt;
    __device__ __forceinline__ bool next(int i, Unit& u) const { if (!StaticOrder::next(i, u)) return false; tile_info(tt, u); return true; }
    __device__ __forceinline__ const char* a_ptr(const Unit& u) const { return H + (size_t)u.pm * BM * 1024; }
    __device__ __forceinline__ const char* b_ptr(const Unit& u, int t) const { const int e = t < 4 ? u.ea : u.eb; return W2 + (size_t)e * (DM * FF) + (size_t)u.pn * (BM * FF) + (size_t)(t & 3) * 128; }
};

__device__ __forceinline__ float fast_sigmoid(float v) { return __builtin_amdgcn_rcpf(1.0f + __builtin_amdgcn_exp2f(-1.4426950408889634f * v)); }
__device__ __forceinline__ void unpack8(u32x4 v, float (&f)[8]) { f[0] = __uint_as_float(v.x << 16); f[1] = __uint_as_float(v.x & 0xffff0000u); f[2] = __uint_as_float(v.y << 16); f[3] = __uint_as_float(v.y & 0xffff0000u);
    f[4] = __uint_as_float(v.z << 16); f[5] = __uint_as_float(v.z & 0xffff0000u); f[6] = __uint_as_float(v.w << 16); f[7] = __uint_as_float(v.w & 0xffff0000u); }
struct EpiZ {
    unsigned char* ws; const float* q_norm; const float* k_norm; const float* rinvx; LAS unsigned char* ldsx;
    __device__ __forceinline__ void operator()(const f32x4 (&acc)[2][2][4][2], const Unit& u, int wr, int wc, int fr, int fq) const {
        const int region = u.pn >> 1, cbase = (u.pn & 1) * 256 + wc * 64 + 8 * fq;
        bf16_t* base = (bf16_t*)(ws + WS_Q + (size_t)region * (32 * MiB));
        const int row0 = u.pm * BM + wr * 64 + fr;
        float rx[2][4];
#pragma unroll
        for (int ai = 0; ai < 2; ++ai)
#pragma unroll
            for (int m = 0; m < 4; ++m) rx[ai][m] = rinvx[row0 + ai * HALF + m * 16];
        if (region < 2) {
            const float* gp = region ? k_norm : q_norm; const float qs = region ? 1.0f : 0.125f * 1.4426950408889634f;
            f32x4 g[2][2];
#pragma unroll
            for (int bj = 0; bj < 2; ++bj)
#pragma unroll
                for (int n = 0; n < 2; ++n) g[bj][n] = *(const f32x4*)(gp + 32 * bj + 8 * fq + 4 * n) * qs;
            const float* ropet = (const float*)(ws + WS_ROPE);
            f32x4 ncs0, ncs1, nsn0, nsn1;
            { const int pos = row0 & (SEQ - 1); ncs0 = *(const f32x4*)(ropet + (size_t)pos * 8); ncs1 = *(const f32x4*)(ropet + (size_t)pos * 8 + 4); nsn0 = *(const f32x4*)(ropet + 65536 + (size_t)pos * 8); nsn1 = *(const f32x4*)(ropet + 65536 + (size_t)pos * 8 + 4); }
#pragma unroll
            for (int ai = 0; ai < 2; ++ai)
#pragma unroll
                for (int m = 0; m < 4; ++m) {
                    const int r = row0 + ai * HALF + m * 16;
                    const f32x4 cs0 = ncs0, cs1 = ncs1, sn0 = nsn0, sn1 = nsn1;
                    if (ai * 4 + m < 7) { const int g1 = ai * 4 + m + 1; const int pos = (row0 + (g1 >> 2) * HALF + (g1 & 3) * 16) & (SEQ - 1);
                        ncs0 = *(const f32x4*)(ropet + (size_t)pos * 8); ncs1 = *(const f32x4*)(ropet + (size_t)pos * 8 + 4); nsn0 = *(const f32x4*)(ropet + 65536 + (size_t)pos * 8); nsn1 = *(const f32x4*)(ropet + 65536 + (size_t)pos * 8 + 4); }
                    f32x4 v[2][2]; float ss = 0.f;
#pragma unroll
                    for (int bj = 0; bj < 2; ++bj)
#pragma unroll
                        for (int n = 0; n < 2; ++n) { const f32x4 x = acc[ai][bj][m][n] * rx[ai][m]; v[bj][n] = x; ss += (x[0] * x[0] + x[1] * x[1]) + (x[2] * x[2] + x[3] * x[3]); }
                    ss += __shfl_xor(ss, 16); ss += __shfl_xor(ss, 32);
                    const float ri = 1.0f / sqrtf(ss * (1.0f / 64.f) + EPS);
#pragma unroll
                    for (int bj = 0; bj < 2; ++bj)
#pragma unroll
                        for (int n = 0; n < 2; ++n) v[bj][n] = v[bj][n] * ri * g[bj][n];
#pragma unroll
                    for (int n = 0; n < 2; ++n) {
                        const f32x4 cs = n ? cs1 : cs0, sn = n ? sn1 : sn0;
#pragma unroll
                        for (int e = 0; e < 4; ++e) {
                            const float own = v[0][n][e], partner = __shfl_xor(own, 16);
                            const float rot = fq == 0 ? own * cs[e] - partner * sn[e] : own * cs[e] + partner * sn[e];
                            v[0][n][e] = fq < 2 ? rot : own;
                        }
                    }
                    bf16_t* rowp = base + (size_t)r * AW + cbase;
#pragma unroll
                    for (int bj = 0; bj < 2; ++bj) { u32x4 w; w.x = cvt_pk_bf16(v[bj][0][0], v[bj][0][1]); w.y = cvt_pk_bf16(v[bj][0][2], v[bj][0][3]); w.z = cvt_pk_bf16(v[bj][1][0], v[bj][1][1]); w.w = cvt_pk_bf16(v[bj][1][2], v[bj][1][3]);
                        *(u32x4*)(rowp + 32 * bj) = w; }
                }
        } else if (u.pn >= 8) {
            bf16_t* ub = (bf16_t*)(ws + WS_CC) + (u.pn - 8) * 128 + wc * 32 + 8 * fq;
#pragma unroll
            for (int ai = 0; ai < 2; ++ai)
#pragma unroll
                for (int m = 0; m < 4; ++m) { const float s2 = rx[ai][m] * rx[ai][m]; const f32x4 v0 = acc[ai][0][m][0] * acc[ai][1][m][0] * s2, v1 = acc[ai][0][m][1] * acc[ai][1][m][1] * s2;
                    u32x4 w; w.x = cvt_pk_bf16(v0[0], v0[1]); w.y = cvt_pk_bf16(v0[2], v0[3]); w.z = cvt_pk_bf16(v1[0], v1[1]); w.w = cvt_pk_bf16(v1[2], v1[3]);
                    *(u32x4*)(ub + (size_t)(row0 + ai * HALF + m * 16) * AW) = w; }
        } else if (region == 3) {
            LAS unsigned char* const ob = ldsx + (wr * 4 + wc) * 2048; const int ln = fq * 16 + fr;
#pragma unroll
            for (int ai = 0; ai < 2; ++ai)
#pragma unroll
                for (int m = 0; m < 4; ++m) { const float s = rx[ai][m];
#pragma unroll
                    for (int bj = 0; bj < 2; ++bj) { const f32x4 v0 = acc[ai][bj][m][0] * s, v1 = acc[ai][bj][m][1] * s; u32x4 w; w.x = cvt_pk_bf16(v0[0], v0[1]); w.y = cvt_pk_bf16(v0[2], v0[3]); w.z = cvt_pk_bf16(v1[0], v1[1]); w.w = cvt_pk_bf16(v1[2], v1[3]);
                        *(LAS u32x4*)(ob + fr * 128 + (((4 * bj + fq) ^ (fr & 7)) << 4)) = w; }
                    asm volatile("s_waitcnt lgkmcnt(0)" ::: "memory");
#pragma unroll
                    for (int h = 0; h < 2; ++h) { const int rr = (ln >> 3) + 8 * h, cl = ln & 7; const u32x4 v = *(const LAS u32x4*)(ob + rr * 128 + ((cl ^ (rr & 7)) << 4));
                        __builtin_nontemporal_store(v, (u32x4*)(base + (size_t)(row0 - fr + ai * HALF + m * 16 + rr) * AW + (u.pn & 1) * 256 + wc * 64 + cl * 8)); }
                    asm volatile("s_waitcnt lgkmcnt(0)" ::: "memory"); }
        } else {
#pragma unroll
            for (int ai = 0; ai < 2; ++ai)
#pragma unroll
                for (int m = 0; m < 4; ++m) { bf16_t* rowp = base + (size_t)(row0 + ai * HALF + m * 16) * AW + cbase; const float s = rx[ai][m];
#pragma unroll
                    for (int bj = 0; bj < 2; ++bj) { const f32x4 v0 = acc[ai][bj][m][0] * s, v1 = acc[ai][bj][m][1] * s; u32x4 w; w.x = cvt_pk_bf16(v0[0], v0[1]); w.y = cvt_pk_bf16(v0[2], v0[3]); w.z = cvt_pk_bf16(v1[0], v1[1]); w.w = cvt_pk_bf16(v1[2], v1[3]);
                        *(u32x4*)(rowp + 32 * bj) = w; } }
        }
    }
};
struct EpiU {
    unsigned char* U; float* ssq; const float* gpost;
    __device__ __forceinline__ void operator()(const f32x4 (&acc)[2][2][4][2], const Unit& u, int wr, int wc, int fr, int fq) const {
        const int row0 = u.pm * BM + wr * 64 + fr, col0 = u.pn * BM + wc * 32 + 8 * fq;
        f32x4 gv[2][2];
#pragma unroll
        for (int bj = 0; bj < 2; ++bj)
#pragma unroll
            for (int n = 0; n < 2; ++n) gv[bj][n] = *(const f32x4*)(gpost + col0 + bj * HALF + 4 * n);
#pragma unroll
        for (int ai = 0; ai < 2; ++ai)
#pragma unroll
            for (int m = 0; m < 4; ++m) { const int r = row0 + ai * HALF + m * 16; unsigned char* rowp = U + (size_t)r * DM + col0; float ss = 0.f;
#pragma unroll
                for (int bj = 0; bj < 2; ++bj) { const f32x4 v0 = acc[ai][bj][m][0] * (1.0f / (F8_SPB * F8_SWP)), v1 = acc[ai][bj][m][1] * (1.0f / (F8_SPB * F8_SWP));
                    ss += (v0[0] * v0[0] + v0[1] * v0[1]) + (v0[2] * v0[2] + v0[3] * v0[3]) + (v1[0] * v1[0] + v1[1] * v1[1]) + (v1[2] * v1[2] + v1[3] * v1[3]);
                    const f32x4 g0 = v0 * gv[bj][0] * F8_SU, g1 = v1 * gv[bj][1] * F8_SU;
                    u32x2 w; w.x = pk4_fp8(g0[0], g0[1], g0[2], g0[3]); w.y = pk4_fp8(g1[0], g1[1], g1[2], g1[3]);
                    *(u32x2*)(rowp + bj * HALF) = w; }
                ss += __shfl_xor(ss, 16); ss += __shfl_xor(ss, 32);
                if (fq == 0) ssq[(size_t)r * 16 + u.pn * 4 + wc] = ss; }
    }
};

struct EpiO {
    const bf16_t* xb; bf16_t* h1b; unsigned char* h1f8;
    __device__ __forceinline__ void operator()(const f32x4 (&acc)[2][2][4][2], const Unit& u, int wr, int wc, int fr, int fq) const {
        const int row0 = u.pm * BM + wr * 64 + fr, col0 = u.pn * BM + wc * 32 + 8 * fq;
        u32x4 bx0[4], bx1[4];
#define EO_ISSUE(G) { const size_t o_ = (size_t)(row0 + ((G) >> 2) * HALF + ((G) & 3) * 16) * DM + col0; bx0[(G) & 3] = __builtin_nontemporal_load((const u32x4*)(xb + o_)); bx1[(G) & 3] = __builtin_nontemporal_load((const u32x4*)(xb + o_ + HALF)); }
        EO_ISSUE(0) EO_ISSUE(1) EO_ISSUE(2)
#pragma unroll
        for (int g = 0; g < 8; ++g) { const int ai = g >> 2, m = g & 3; const size_t off = (size_t)(row0 + ai * HALF + m * 16) * DM + col0;
            if (g + 3 < 8) EO_ISSUE(g + 3)
            const u32x4 x0 = bx0[g & 3], x1 = bx1[g & 3];
#pragma unroll
            for (int bj = 0; bj < 2; ++bj) { float hv[8]; unpack8(bj ? x1 : x0, hv);
#pragma unroll
                for (int n = 0; n < 2; ++n)
#pragma unroll
                    for (int e = 0; e < 4; ++e) hv[4 * n + e] += acc[ai][bj][m][n][e];
                u32x4 w; w.x = cvt_pk_bf16(hv[0], hv[1]); w.y = cvt_pk_bf16(hv[2], hv[3]); w.z = cvt_pk_bf16(hv[4], hv[5]); w.w = cvt_pk_bf16(hv[6], hv[7]); *(u32x4*)(h1b + off + bj * HALF) = w;
                u32x2 w8; w8.x = pk4_fp8(hv[0] * F8_SA, hv[1] * F8_SA, hv[2] * F8_SA, hv[3] * F8_SA); w8.y = pk4_fp8(hv[4] * F8_SA, hv[5] * F8_SA, hv[6] * F8_SA, hv[7] * F8_SA); *(u32x2*)(h1f8 + off + bj * HALF) = w8; } }
    }
};
struct EpiM1 {
    unsigned char* H; const u32x4* rec;
    __device__ __forceinline__ void operator()(const f32x4 (&acc)[2][2][4][2], const Unit& u, int wr, int wc, int fr, int fq) const {
        const int rl0 = wr * 64 + fr, col0 = (u.pn >> 2) * 512 + (u.pn & 3) * 128 + wc * 32 + 8 * fq;
        const int pos0 = u.pm * BM - u.base; const u32x4* rb = rec + (size_t)u.b * T; const bool ea = u.pn < 4;
        float riv[2][4], gtv[2][4];
#pragma unroll
        for (int ai = 0; ai < 2; ++ai)
#pragma unroll
            for (int m = 0; m < 4; ++m) { const int pos = pos0 + rl0 + ai * HALF + m * 16; const bool ok = pos < u.cnt; const u32x4 q = rb[ok ? pos : 0];
                riv[ai][m] = ok ? __uint_as_float(q.y) : 0.f; gtv[ai][m] = ok ? __uint_as_float(ea ? q.z : q.w) : 0.f; }
#pragma unroll
        for (int ai = 0; ai < 2; ++ai)
#pragma unroll
            for (int m = 0; m < 4; ++m) { const int sr = u.pm * BM + rl0 + ai * HALF + m * 16; const float ri = riv[ai][m], gate = gtv[ai][m];
                float o[8];
#pragma unroll
                for (int n = 0; n < 2; ++n)
#pragma unroll
                    for (int e = 0; e < 4; ++e) { const float a = acc[ai][0][m][n][e] * ri, b = acc[ai][1][m][n][e] * ri; o[4 * n + e] = gate * (a * fast_sigmoid(a)) * b; }
                u32x2 w; w.x = pk4_fp8(o[0], o[1], o[2], o[3]); w.y = pk4_fp8(o[4], o[5], o[6], o[7]);
                *(u32x2*)(H + (size_t)sr * 1024 + col0) = w; }
    }
};
struct EpiM2 {
    const bf16_t* h1b; unsigned char* h2lo; float* ssq; const int* list; unsigned char* h2f8;
    __device__ __forceinline__ void operator()(const f32x4 (&acc)[2][2][4][2], const Unit& u, int wr, int wc, int fr, int fq) const {
        const int rl0 = wr * 64 + fr, col0 = u.pn * BM + wc * 32 + 8 * fq; const int pos0 = u.pm * BM - u.base; const int* lb = list + (size_t)u.b * T * 4;
        int tok[2][4];
#pragma unroll
        for (int ai = 0; ai < 2; ++ai)
#pragma unroll
            for (int m = 0; m < 4; ++m) { const int pos = pos0 + rl0 + ai * HALF + m * 16; tok[ai][m] = pos < u.cnt ? lb[pos * 4] : -1; }
        u32x4 n0, n1;
        { const int t0 = tok[0][0]; const size_t o0 = (size_t)(t0 >= 0 ? t0 : 0) * DM + col0; n0 = *(const u32x4*)(h1b + o0); n1 = *(const u32x4*)(h1b + o0 + HALF); }
#pragma unroll
        for (int g = 0; g < 8; ++g) { const int ai = g >> 2, m = g & 3; const int tk = tok[ai][m]; const bool ok = tk >= 0; const size_t off = (size_t)(ok ? tk : 0) * DM + col0;
                const u32x4 hb0 = n0, hb1 = n1; float ss = 0.f;
                if (g < 7) { const int t2 = tok[(g + 1) >> 2][(g + 1) & 3]; const size_t o2 = (size_t)(t2 >= 0 ? t2 : 0) * DM + col0; n0 = *(const u32x4*)(h1b + o2); n1 = *(const u32x4*)(h1b + o2 + HALF); }
#pragma unroll
                for (int bj = 0; bj < 2; ++bj) { float hv[8]; unpack8(bj ? hb1 : hb0, hv);
#pragma unroll
                    for (int n = 0; n < 2; ++n)
#pragma unroll
                        for (int e = 0; e < 4; ++e) { hv[4 * n + e] += acc[ai][bj][m][n][e] * (1.0f / (F8_SH * F8_SW2)); ss += hv[4 * n + e] * hv[4 * n + e]; }
                    u32x2 w8; w8.x = pk4_fp8(hv[0] * F8_SA2, hv[1] * F8_SA2, hv[2] * F8_SA2, hv[3] * F8_SA2); w8.y = pk4_fp8(hv[4] * F8_SA2, hv[5] * F8_SA2, hv[6] * F8_SA2, hv[7] * F8_SA2);
                    const f32x2_t d0 = __builtin_amdgcn_cvt_pk_f32_fp8((int)w8.x, false), d1 = __builtin_amdgcn_cvt_pk_f32_fp8((int)w8.x, true), d2 = __builtin_amdgcn_cvt_pk_f32_fp8((int)w8.y, false), d3 = __builtin_amdgcn_cvt_pk_f32_fp8((int)w8.y, true);
                    u32x2 wl; wl.x = pk4_fp8((hv[0] * F8_SA2 - d0.x) * 16.f, (hv[1] * F8_SA2 - d0.y) * 16.f, (hv[2] * F8_SA2 - d1.x) * 16.f, (hv[3] * F8_SA2 - d1.y) * 16.f);
                    wl.y = pk4_fp8((hv[4] * F8_SA2 - d2.x) * 16.f, (hv[5] * F8_SA2 - d2.y) * 16.f, (hv[6] * F8_SA2 - d3.x) * 16.f, (hv[7] * F8_SA2 - d3.y) * 16.f);
                    if (ok) { *(u32x2*)(h2lo + off + bj * HALF) = wl; *(u32x2*)(h2f8 + off + bj * HALF) = w8; } }
                ss += __shfl_xor(ss, 16); ss += __shfl_xor(ss, 32);
                if (ok && fq == 0) ssq[(size_t)tk * 16 + u.pn * 4 + wc] = ss; }
    }
};
struct EpiG {
    float* out; const unsigned char* h2hi; const unsigned char* h2lo; const unsigned char* U; const float* ssq2; const float* ssqu; LAS unsigned char* ldsx;
    __device__ __forceinline__ void operator()(const f32x4 (&acc)[2][2][4][2], const Unit& u, int wr, int wc, int fr, int fq) const {
        const int row0 = u.pm * BM + wr * 64 + fr, col0 = u.pn * BM + wc * 32 + 8 * fq;
        LAS unsigned char* const ob = ldsx + (wr * 4 + wc) * 2048; const int ln = fq * 16 + fr;
        u32x2 bh0[4], bh1[4], bl0[4], bl1[4], bu0[4], bu1[4];
#define EG_ISSUE(G) { const size_t o_ = (size_t)(row0 + ((G) >> 2) * HALF + ((G) & 3) * 16) * DM + col0; bh0[(G) & 3] = *(const u32x2*)(h2hi + o_); bh1[(G) & 3] = *(const u32x2*)(h2hi + o_ + HALF); bl0[(G) & 3] = *(const u32x2*)(h2lo + o_); bl1[(G) & 3] = *(const u32x2*)(h2lo + o_ + HALF); bu0[(G) & 3] = *(const u32x2*)(U + o_); bu1[(G) & 3] = *(const u32x2*)(U + o_ + HALF); }
        EG_ISSUE(0) EG_ISSUE(1) EG_ISSUE(2)
        float r2v[8], ruv[8];
#pragma unroll
        for (int g = 0; g < 8; ++g) { const int r = row0 + (g >> 2) * HALF + (g & 3) * 16;
            const f32x4 a = *(const f32x4*)(ssq2 + (size_t)r * 16 + 4 * fq), b = *(const f32x4*)(ssqu + (size_t)r * 16 + 4 * fq); float s2 = (a[0] + a[1]) + (a[2] + a[3]), su = (b[0] + b[1]) + (b[2] + b[3]);
            s2 += __shfl_xor(s2, 16); su += __shfl_xor(su, 16); s2 += __shfl_xor(s2, 32); su += __shfl_xor(su, 32);
            r2v[g] = (1.0f / (F8_SA2 * F8_SWG)) / sqrtf(s2 * (1.0f / 1024.f) + EPS); ruv[g] = (1.0f / F8_SU) / sqrtf(su * (1.0f / 1024.f) + EPS); }
#pragma unroll
        for (int g = 0; g < 8; ++g) { const int ai = g >> 2, m = g & 3; const int r = row0 + ai * HALF + m * 16; const size_t off = (size_t)r * DM + col0;
                if (g + 3 < 8) EG_ISSUE(g + 3)
                const u32x2 hb0 = bh0[g & 3], hb1 = bh1[g & 3], lb0 = bl0[g & 3], lb1 = bl1[g & 3], ub0 = bu0[g & 3], ub1 = bu1[g & 3];
                const float r2 = r2v[g], ru = ruv[g];
#pragma unroll
                for (int bj = 0; bj < 2; ++bj) { float hv[8], uv[8];
                    { const u32x2 hh = bj ? hb1 : hb0, ll = bj ? lb1 : lb0;
                      const f32x2_t a0 = __builtin_amdgcn_cvt_pk_f32_fp8((int)hh.x, false), a1 = __builtin_amdgcn_cvt_pk_f32_fp8((int)hh.x, true), a2 = __builtin_amdgcn_cvt_pk_f32_fp8((int)hh.y, false), a3 = __builtin_amdgcn_cvt_pk_f32_fp8((int)hh.y, true);
                      const f32x2_t c0 = __builtin_amdgcn_cvt_pk_f32_fp8((int)ll.x, false), c1 = __builtin_amdgcn_cvt_pk_f32_fp8((int)ll.x, true), c2 = __builtin_amdgcn_cvt_pk_f32_fp8((int)ll.y, false), c3 = __builtin_amdgcn_cvt_pk_f32_fp8((int)ll.y, true);
                      constexpr float s1 = 1.0f / F8_SA2, s2 = 1.0f / (16.f * F8_SA2);
                      hv[0] = a0.x * s1 + c0.x * s2; hv[1] = a0.y * s1 + c0.y * s2; hv[2] = a1.x * s1 + c1.x * s2; hv[3] = a1.y * s1 + c1.y * s2; hv[4] = a2.x * s1 + c2.x * s2; hv[5] = a2.y * s1 + c2.y * s2; hv[6] = a3.x * s1 + c3.x * s2; hv[7] = a3.y * s1 + c3.y * s2; }
                    { const u32x2 uu = bj ? ub1 : ub0; const f32x2_t q0 = __builtin_amdgcn_cvt_pk_f32_fp8((int)uu.x, false), q1 = __builtin_amdgcn_cvt_pk_f32_fp8((int)uu.x, true), q2 = __builtin_amdgcn_cvt_pk_f32_fp8((int)uu.y, false), q3 = __builtin_amdgcn_cvt_pk_f32_fp8((int)uu.y, true);
                      uv[0] = q0.x; uv[1] = q0.y; uv[2] = q1.x; uv[3] = q1.y; uv[4] = q2.x; uv[5] = q2.y; uv[6] = q3.x; uv[7] = q3.y; }
#pragma unroll
                    for (int n = 0; n < 2; ++n) { f32x4 res;
#pragma unroll
                        for (int e = 0; e < 4; ++e) res[e] = hv[4 * n + e] + fast_sigmoid(acc[ai][bj][m][n][e] * r2) * (uv[4 * n + e] * ru);
                        *(LAS f32x4*)(ob + fr * 128 + (((2 * fq + n) ^ (fr & 7)) << 4)) = res; }
                    asm volatile("s_waitcnt lgkmcnt(0)" ::: "memory");
#pragma unroll
                    for (int h = 0; h < 2; ++h) { const int rr = (ln >> 3) + 8 * h, cl = ln & 7; const f32x4 v = *(const LAS f32x4*)(ob + rr * 128 + ((cl ^ (rr & 7)) << 4));
                        __builtin_nontemporal_store(v, (f32x4*)(out + (size_t)(r - fr + rr) * DM + (col0 - 8 * fq) + bj * HALF + 4 * cl)); }
                    asm volatile("s_waitcnt lgkmcnt(0)" ::: "memory"); } }
#undef EG_ISSUE
    }
};
}

template <class RowMap>
__device__ __forceinline__ void p0_transpose_item(const float* W, int ldw, bf16_t* WT, int Kdst, LAS float* scr, int k0, int n0, int lane, const float* kscale, RowMap rowmap, float f8scale = 0.f) {
    f32x4 ld[8];
#pragma unroll
    for (int i = 0; i < 8; ++i) ld[i] = __builtin_nontemporal_load((const f32x4*)(W + (size_t)(k0 + 8 * i + (lane >> 3)) * ldw + n0 + 4 * (lane & 7)));
#pragma unroll
    for (int i = 0; i < 8; ++i) { const int kk = 8 * i + (lane >> 3); const float sc = kscale ? kscale[k0 + kk] : 1.0f; LAS float* d = scr + kk * 33 + 4 * (lane & 7);
        d[0] = ld[i].x * sc; d[1] = ld[i].y * sc; d[2] = ld[i].z * sc; d[3] = ld[i].w * sc; }
    asm volatile("s_waitcnt lgkmcnt(0)" ::: "memory");
    const int c = lane & 7;
#pragma unroll
    for (int j = 0; j < 4; ++j) { const int n = (lane >> 3) + 8 * j; const LAS float* s = scr + (8 * c) * 33 + n;
        pg8::u32x4 o; o.x = f2bf(s[0 * 33]) | (f2bf(s[1 * 33]) << 16); o.y = f2bf(s[2 * 33]) | (f2bf(s[3 * 33]) << 16); o.z = f2bf(s[4 * 33]) | (f2bf(s[5 * 33]) << 16); o.w = f2bf(s[6 * 33]) | (f2bf(s[7 * 33]) << 16);
        if (f8scale == 0.f) *(pg8::u32x4*)(WT + (size_t)rowmap(n0 + n) * Kdst + k0 + 8 * c) = o;
        else { pg8::u32x2 o8; o8.x = pg8::pk4_fp8(s[0 * 33] * f8scale, s[1 * 33] * f8scale, s[2 * 33] * f8scale, s[3 * 33] * f8scale); o8.y = pg8::pk4_fp8(s[4 * 33] * f8scale, s[5 * 33] * f8scale, s[6 * 33] * f8scale, s[7 * 33] * f8scale);
            *(pg8::u32x2*)((unsigned char*)WT + (size_t)rowmap(n0 + n) * Kdst + k0 + 8 * c) = o8; } }
    asm volatile("s_waitcnt lgkmcnt(0)" ::: "memory");
}
__device__ __forceinline__ int rm_head(int lc) { const int wc = lc >> 6, d = lc & 63; return 128 * (d >> 5) + 32 * wc + 16 * ((d >> 2) & 1) + 4 * ((d >> 3) & 3) + (d & 3); }
__device__ __forceinline__ int rm_perm(int lc) { const int bj = lc >> 7, wc = (lc >> 5) & 3, j = lc & 31; return 128 * bj + 32 * wc + 16 * ((j >> 2) & 1) + 4 * ((j >> 3) & 3) + (j & 3); }
__device__ __forceinline__ void p0_weights(const P& p, LAS unsigned char* lds, int vw, int nvw, int wave, int lane, int lo, int hi) {
    LAS float* scr = (LAS float*)(lds + wave * 16384);
    unsigned char* ws = p.ws;
    auto perm = [](int c) { return (c & ~255) + rm_perm(c & 255); };
    constexpr int I_IN = 16 * 96, I_OUT = 16 * 32, I_G = 16 * 32, I_P = 4 * 32, I_1 = 16 * 16 * 16, I_3 = I_1, I_2 = 16 * 8 * 32;
    constexpr int NIT = I_IN + I_OUT + I_G + I_P + I_1 + I_3 + I_2;
    constexpr int NIT0 = I_IN + I_OUT + I_G + I_P;
    for (int it = lo + vw; it < hi; it += nvw) {
        int r = it;
        if (r < I_IN) { const int kb = r / 96, nb = r % 96; p0_transpose_item(p.w_in, NZ, (bf16_t*)(ws + WS_WIN), DM, scr, 64 * kb, 32 * nb, lane, p.g_mix, [](int c) {
            if (c < 2048) return (c & ~255) + rm_head(c & 255);
            const int is_ch = c >= 2560, j = (c - 2048) & 511;
            return 256 * (8 + (j >> 7)) + rm_perm(is_ch * 128 + (j & 127)); }); continue; } r -= I_IN;
        if (r < I_OUT) { const int kb = r / 32, nb = r % 32; p0_transpose_item(p.w_out, DM, (bf16_t*)(ws + WS_WOUT), DM, scr, 64 * kb, 32 * nb, lane, nullptr, perm); continue; } r -= I_OUT;
        if (r < I_G) { const int kb = r / 32, nb = r % 32; p0_transpose_item(p.w_ple_gate, DM, (bf16_t*)(ws + WS_WG), DM, scr, 64 * kb, 32 * nb, lane, p.g_ple, perm, pg8::F8_SWG); continue; } r -= I_G;
        if (r < I_P) { const int kb = r / 32, nb = r % 32; p0_transpose_item(p.w_ple_proj, DM, (bf16_t*)(ws + WS_WP), PLE, scr, 64 * kb, 32 * nb, lane, nullptr, perm, pg8::F8_SWP); continue; } r -= I_P;
        if (r < I_1 + I_3) {
            const int is3 = r >= I_1; if (is3) r -= I_1;
            const int e = r / 256, kb = (r % 256) / 16, nb = r % 16;
            const float* W = (is3 ? p.w3 : p.w1) + (size_t)e * DM * FF;
            bf16_t* WT = (bf16_t*)(ws + WS_W13 + (size_t)e * 1024 * DM);
            p0_transpose_item(W, FF, WT, DM, scr, 64 * kb, 32 * nb, lane, p.g_ffn, [is3](int j) { const int q = j >> 7, jl = j & 127; return 256 * q + rm_perm(is3 * 128 + jl); }, pg8::F8_SW1);
            continue; } r -= I_1 + I_3;
        { const int e = r / 256, kb = (r % 256) / 32, nb = r % 32;
          p0_transpose_item(p.w2 + (size_t)e * FF * DM, DM, (bf16_t*)(ws + WS_W2 + (size_t)e * DM * FF), FF, scr, 64 * kb, 32 * nb, lane, nullptr, perm, pg8::F8_SW2); }
    }
}
__device__ __forceinline__ void p0_rope(const P& p, int gw, int ngw, int lane);
__device__ __forceinline__ void p0_prologue(const P& p, LAS unsigned char* lds, int gw, int ngw, int wave, int lane) {
    unsigned char* ws = p.ws;
    p0_weights(p, lds, gw, ngw, wave, lane, 0, 1536);
    p0_rope(p, gw, ngw, lane);
    { bf16_t* xb = (bf16_t*)(ws + WS_XB); float* rinvx = (float*)(ws + WS_RINVX);
      for (int r = gw; r < T; r += 4 * ngw) {
          f32x4 v[4][4]; float a[4];
#pragma unroll
          for (int q = 0; q < 4; ++q) { const f32x4* s0 = (const f32x4*)(p.x + (size_t)(r + q * ngw) * DM);
#pragma unroll
              for (int j = 0; j < 4; ++j) v[q][j] = __builtin_nontemporal_load(s0 + lane + 64 * j); }
#pragma unroll
          for (int q = 0; q < 4; ++q) { a[q] = 0.f;
#pragma unroll
              for (int j = 0; j < 4; ++j) a[q] += v[q][j].x * v[q][j].x + v[q][j].y * v[q][j].y + v[q][j].z * v[q][j].z + v[q][j].w * v[q][j].w; }
#pragma unroll
          for (int o = 1; o < 64; o <<= 1) {
#pragma unroll
              for (int q = 0; q < 4; ++q) a[q] += __shfl_xor(a[q], o); }
#pragma unroll
          for (int q = 0; q < 4; ++q) { if (lane == 0) rinvx[r + q * ngw] = 1.0f / sqrtf(a[q] * (1.0f / 1024.f) + EPS);
#pragma unroll
              for (int j = 0; j < 4; ++j) { pg8::u32x2 w0; w0.x = pg8::cvt_pk_bf16(v[q][j].x, v[q][j].y); w0.y = pg8::cvt_pk_bf16(v[q][j].z, v[q][j].w); *(pg8::u32x2*)(xb + (size_t)(r + q * ngw) * DM + 4 * (lane + 64 * j)) = w0; } }
      } }
}
__device__ __forceinline__ void p0_late(const P& p, int gw, int ngw, int lane, int what, int part = -1) {
    unsigned char* ws = p.ws;
    if (what == 1) { const size_t n8 = (size_t)T * PLE / 8, stride = (size_t)ngw * 64; pg8::u32x2* pb = (pg8::u32x2*)(ws + WS_PB);
      const size_t ib = (size_t)gw * 64 + lane + (part > 0 ? (size_t)part * 4 * stride : 0), ie = part >= 0 ? ib + 1 : n8;
      for (size_t i = ib; i < ie && i < n8; i += 4 * stride) {
          f32x4 a[4], b[4];
#pragma unroll
          for (int q = 0; q < 4; ++q) { a[q] = __builtin_nontemporal_load((const f32x4*)p.p + 2 * (i + q * stride)); b[q] = __builtin_nontemporal_load((const f32x4*)p.p + 2 * (i + q * stride) + 1); }
#pragma unroll
          for (int q = 0; q < 4; ++q) { constexpr float S = pg8::F8_SPB; pg8::u32x2 o; o.x = pg8::pk4_fp8(a[q].x * S, a[q].y * S, a[q].z * S, a[q].w * S); o.y = pg8::pk4_fp8(b[q].x * S, b[q].y * S, b[q].z * S, b[q].w * S); __builtin_nontemporal_store(o, pb + i + q * stride); } } }
    if (what == 0) { for (int idx = gw * 64 + lane; idx < 32 * 2 * 64; idx += ngw * 64) { const int ks = idx >> 7, ct = (idx >> 6) & 1, l = idx & 63, e = 16 * ct + (l & 15), kq = l >> 4;
          unsigned hi[8], lo[8];
#pragma unroll
          for (int j = 0; j < 8; ++j) { const int k = 32 * ks + 8 * kq + j; float w = e < 4 ? p.w_rg[k * 4 + e] : (e < 20 ? p.w_re[k * 16 + (e - 4)] : 0.f); w *= p.g_ffn[k]; hi[j] = f2bf(w); lo[j] = f2bf(w - bf2f(hi[j])); }
          pg8::u32x4 oh, ol; oh.x = hi[0] | (hi[1] << 16); oh.y = hi[2] | (hi[3] << 16); oh.z = hi[4] | (hi[5] << 16); oh.w = hi[6] | (hi[7] << 16); ol.x = lo[0] | (lo[1] << 16); ol.y = lo[2] | (lo[3] << 16); ol.z = lo[4] | (lo[5] << 16); ol.w = lo[6] | (lo[7] << 16);
          ((pg8::u32x4*)(ws + WS_WRH))[idx] = oh; ((pg8::u32x4*)(ws + WS_WRL))[idx] = ol; } }
}
__device__ __forceinline__ void p0_rope(const P& p, int gw, int ngw, int lane) {
    unsigned char* ws = p.ws;
    { float* rt = (float*)(ws + WS_ROPE);
      for (int i = gw * 64 + lane; i < SEQ * 8; i += ngw * 64) { const int pos = i >> 3, fi = i & 7; float inv = p.inv_freq[0];
#pragma unroll
          for (int q = 1; q < 8; ++q) inv = (fi == q) ? p.inv_freq[q] : inv;
          const float ang = (float)pos * inv; rt[i] = cosf(ang); rt[65536 + i] = sinf(ang); } }
}

namespace att {
typedef unsigned u32x4 __attribute__((ext_vector_type(4)));
}
namespace att {
typedef short bf16x8 __attribute__((ext_vector_type(8)));
typedef short s16x4 __attribute__((ext_vector_type(4)));
typedef unsigned u32x4 __attribute__((ext_vector_type(4)));
constexpr int VPITCH = 192, OPITCH = 144, KPITCH = 144;
__device__ __forceinline__ int crow(int r, int hi) { return (r & 3) + 8 * (r >> 2) + 4 * hi; }
__device__ __forceinline__ unsigned cvtpk(float lo, float hi) { unsigned r; asm volatile("v_cvt_pk_bf16_f32 %0, %1, %2" : "=v"(r) : "v"(lo), "v"(hi)); return r; }
typedef float f32x2_t __attribute__((ext_vector_type(2))); typedef __bf16 bf16x2_t __attribute__((ext_vector_type(2)));
__device__ __forceinline__ unsigned cvtpk_c(float lo, float hi) { f32x2_t v = {lo, hi}; bf16x2_t b = __builtin_convertvector(v, bf16x2_t); return __builtin_bit_cast(unsigned, b); }
__device__ __forceinline__ s16x4 vtr(LAS unsigned char* p) { return __builtin_bit_cast(s16x4, __builtin_amdgcn_ds_read_tr16_b64_v4i16((LAS s16x4*)p)); }

struct AttLane { int kr[4], vr0, vr1; };
template <int C>
__device__ __forceinline__ void att_compute(LAS unsigned char* buf, const AttLane& L, const bf16x8 (&qf)[4], f32x16& o0, f32x16& o1, float& lsum, float bref, int i, int hi) {
    bf16x8 kf[4]; s16x4 vl[2][4];
#pragma unroll
    for (int d0 = 0; d0 < 4; ++d0) kf[d0] = *(LAS bf16x8*)(buf + L.kr[d0]);
#pragma unroll
    for (int q = 0; q < 4; ++q) { vl[0][q] = vtr(buf + 4096 + L.vr0 + q * 1024); vl[1][q] = vtr(buf + 4096 + L.vr1 + q * 1024); }
    asm volatile("s_waitcnt lgkmcnt(0)" ::: "memory");
    f32x16 sa;
#pragma unroll
    for (int r = 0; r < 16; ++r) sa[r] = -bref;
#pragma unroll
    for (int d0 = 0; d0 < 4; ++d0) sa = __builtin_amdgcn_mfma_f32_32x32x16_bf16(kf[d0], qf[d0], sa, 0, 0, 0);
    float pv[16];
#pragma unroll
    for (int r = 0; r < 16; ++r) pv[r] = __builtin_amdgcn_exp2f(sa[r]);
    if (C == 0) {
#pragma unroll
        for (int r = 0; r < 16; ++r) pv[r] = (crow(r, hi) >= i) ? pv[r] : 0.f;
    }
    if (C == 4) {
#pragma unroll
        for (int r = 0; r < 16; ++r) pv[r] = (crow(r, hi) <= i) ? pv[r] : 0.f;
    }
    float ls = 0.f;
#pragma unroll
    for (int r = 0; r < 16; ++r) ls += pv[r];
    lsum += ls;
    u32x4 w0, w1;
    w0.x = cvtpk(pv[0], pv[1]); w0.y = cvtpk(pv[2], pv[3]); w0.z = cvtpk(pv[4], pv[5]); w0.w = cvtpk(pv[6], pv[7]);
    w1.x = cvtpk(pv[8], pv[9]); w1.y = cvtpk(pv[10], pv[11]); w1.z = cvtpk(pv[12], pv[13]); w1.w = cvtpk(pv[14], pv[15]);
    const bf16x8 pa0 = __builtin_bit_cast(bf16x8, w0), pa1 = __builtin_bit_cast(bf16x8, w1);
#define ATT_VB(dh, s2) (bf16x8){vl[dh][2 * (s2)][0], vl[dh][2 * (s2)][1], vl[dh][2 * (s2)][2], vl[dh][2 * (s2)][3], vl[dh][2 * (s2) + 1][0], vl[dh][2 * (s2) + 1][1], vl[dh][2 * (s2) + 1][2], vl[dh][2 * (s2) + 1][3]}
    o0 = __builtin_amdgcn_mfma_f32_32x32x16_bf16(ATT_VB(0, 0), pa0, o0, 0, 0, 0); o1 = __builtin_amdgcn_mfma_f32_32x32x16_bf16(ATT_VB(1, 0), pa0, o1, 0, 0, 0);
    o0 = __builtin_amdgcn_mfma_f32_32x32x16_bf16(ATT_VB(0, 1), pa1, o0, 0, 0, 0); o1 = __builtin_amdgcn_mfma_f32_32x32x16_bf16(ATT_VB(1, 1), pa1, o1, 0, 0, 0);
#undef ATT_VB
}
struct GroupInfo { int dsh, dd, pos0, h, b, s0; size_t tb; };
__device__ __forceinline__ GroupInfo att_group(int k, int blk) {
    const int x = blk & 7, m = blk >> 3; GroupInfo g; g.b = k % 3; const int bh = x + 8 * (k / 3);
    g.h = bh & 7; g.tb = (size_t)(bh >> 3) * SEQ; g.dsh = 2 * g.b; g.dd = 1 << g.dsh;
    const int gper = 32 >> g.dsh, rho = m / gper;
    g.s0 = 8 * (m % gper); g.pos0 = rho + (g.s0 << (5 + g.dsh)); return g;
}
template <int ABL>
__device__ __forceinline__ void attn_phase(const P& p, LAS unsigned char* lds, int gw, int ngw, int wave, int lane) {
    const bf16_t* Q = (const bf16_t*)(p.ws + WS_Q); const bf16_t* Kb = (const bf16_t*)(p.ws + WS_K); const bf16_t* Vb = (const bf16_t*)(p.ws + WS_V);
    LAS unsigned char* obuf = lds + 98304 + wave * 4096;
    const int i = lane & 31, hi = lane >> 5, tid = wave * 64 + lane, blk = (int)blockIdx.x;
    float bref;
    { float a = fabsf(p.q_norm[lane]), b = fabsf(p.k_norm[lane]);
#pragma unroll
      for (int o = 1; o < 64; o <<= 1) { a = fmaxf(a, __shfl_xor(a, o)); b = fmaxf(b, __shfl_xor(b, o)); }
      bref = a * b * (8.0f * 1.4426950408889634f * 1.02f) + 0.25f; }
    AttLane L;
    {
#pragma unroll
      for (int d0 = 0; d0 < 4; ++d0) L.kr[d0] = i * 128 + (((2 * d0 + hi) ^ ((i >> 1) & 7)) << 4);
      const int q_ = (lane & 15) >> 2, p_ = lane & 3, cl = 2 * ((lane >> 4) & 1) + (p_ >> 1), sw4 = ((q_ >> 1) & 1) << 2, rowb = (4 * hi + q_) * 128 + (p_ & 1) * 8;
      L.vr0 = rowb + (((0 ^ sw4) + cl) << 4); L.vr1 = rowb + (((4 ^ sw4) + cl) << 4); }
    const int skv = tid >> 8, srow = (tid >> 3) & 31, sch = tid & 7;
    const int sdst = skv * 4096 + srow * 128 + ((skv ? (sch ^ (((srow >> 1) & 1) << 2)) : (sch ^ ((srow >> 1) & 7))) << 4);
    const bf16_t* sbase = skv ? Vb : Kb;
    constexpr int NROUND = 12;
    u32x4 st[12]; bf16x8 qf[4], qn[4];
#define ATT_GLOAD(g, QD) do { \
        _Pragma("unroll") for (int j = 0; j < 12; ++j) { int pt_ = (g).pos0 + (32 * (j - 4) + srow) * (g).dd; pt_ = pt_ < 0 ? 0 : pt_; st[j] = *(const u32x4*)(sbase + ((g).tb + pt_) * AW + (g).h * 64 + sch * 8); } \
        { const bf16_t* qrow_ = Q + ((g).tb + (g).pos0 + (32 * wave + i) * (g).dd) * AW + (g).h * 64 + 8 * hi; \
          _Pragma("unroll") for (int d0 = 0; d0 < 4; ++d0) QD[d0] = *(const bf16x8*)(qrow_ + 16 * d0); } } while (0)
    GroupInfo cur = att_group(0, blk);
    ATT_GLOAD(cur, qf);
    for (int k = 0; k < NROUND; ++k) {
#pragma unroll
        for (int j = 0; j < 12; ++j) *(LAS u32x4*)(lds + j * 8192 + sdst) = st[j];
        const GroupInfo nx = att_group(k + 1 < NROUND ? k + 1 : k, blk);
        asm volatile("s_waitcnt lgkmcnt(0)" ::: "memory"); __builtin_amdgcn_s_barrier(); asm volatile("" ::: "memory");
        f32x16 o0, o1;
#pragma unroll
        for (int r = 0; r < 16; ++r) { o0[r] = 0.f; o1[r] = 0.f; }
        float lsum = 0.f;
        const int s = cur.s0 + wave, cmin = s >= 4 ? 0 : 4 - s;
        LAS unsigned char* tb0 = lds + wave * 8192;
#define ATT_GLD3(j0) do { _Pragma("unroll") for (int j = (j0); j < (j0) + 3; ++j) { int pt_ = nx.pos0 + (32 * (j - 4) + srow) * nx.dd; pt_ = pt_ < 0 ? 0 : pt_; st[j] = *(const u32x4*)(sbase + (nx.tb + pt_) * AW + nx.h * 64 + sch * 8); } \
        __builtin_amdgcn_sched_barrier(0); } while (0)
        ATT_GLD3(0);
        if (cmin <= 0) att_compute<0>(tb0, L, qf, o0, o1, lsum, bref, i, hi);
        __builtin_amdgcn_sched_barrier(0); ATT_GLD3(3);
        if (cmin <= 1) att_compute<1>(tb0 + 8192, L, qf, o0, o1, lsum, bref, i, hi);
        __builtin_amdgcn_sched_barrier(0); ATT_GLD3(6);
        if (cmin <= 2) att_compute<2>(tb0 + 2 * 8192, L, qf, o0, o1, lsum, bref, i, hi);
        __builtin_amdgcn_sched_barrier(0); ATT_GLD3(9);
        if (cmin <= 3) att_compute<3>(tb0 + 3 * 8192, L, qf, o0, o1, lsum, bref, i, hi);
        __builtin_amdgcn_sched_barrier(0);
        { const bf16_t* qrow_ = Q + (nx.tb + nx.pos0 + (32 * wave + i) * nx.dd) * AW + nx.h * 64 + 8 * hi;
#pragma unroll
          for (int d0 = 0; d0 < 4; ++d0) qn[d0] = *(const bf16x8*)(qrow_ + 16 * d0); }
        __builtin_amdgcn_sched_barrier(0);
        att_compute<4>(tb0 + 4 * 8192, L, qf, o0, o1, lsum, bref, i, hi);
#undef ATT_GLD3
        lsum += __shfl_xor(lsum, 32);
        const int qpos0 = cur.pos0 + 32 * wave * cur.dd;
        bf16_t* PO = (bf16_t*)(p.ws + WS_PO) + (size_t)cur.b * T * AW; float* PL = (float*)(p.ws + WS_PL) + (size_t)cur.b * T * NH;
#pragma unroll
        for (int q4 = 0; q4 < 4; ++q4) {
            const unsigned long long w0 = (unsigned long long)cvtpk_c(o0[4 * q4], o0[4 * q4 + 1]) | ((unsigned long long)cvtpk_c(o0[4 * q4 + 2], o0[4 * q4 + 3]) << 32);
            const unsigned long long w1 = (unsigned long long)cvtpk_c(o1[4 * q4], o1[4 * q4 + 1]) | ((unsigned long long)cvtpk_c(o1[4 * q4 + 2], o1[4 * q4 + 3]) << 32);
            LAS unsigned char* a = obuf + i * 128 + 8 * hi;
            *(LAS unsigned long long*)(a + ((q4 ^ (i & 7)) << 4)) = w0; *(LAS unsigned long long*)(a + (((4 + q4) ^ (i & 7)) << 4)) = w1; }
        asm volatile("s_waitcnt lgkmcnt(0)" ::: "memory");
#pragma unroll
        for (int it = 0; it < 4; ++it) { const int row = it * 8 + (lane >> 3); const u32x4 v = *(LAS u32x4*)(obuf + row * 128 + (lane & 7) * 16); const int lc = (lane & 7) ^ (row & 7);
            __builtin_nontemporal_store(v, (u32x4*)(PO + (cur.tb + qpos0 + row * cur.dd) * AW + cur.h * 64 + lc * 8)); }
        if (hi == 0) PL[(cur.tb + qpos0 + i * cur.dd) * NH + cur.h] = lsum;
        asm volatile("s_waitcnt lgkmcnt(0)" ::: "memory"); __builtin_amdgcn_s_barrier(); asm volatile("" ::: "memory");
        cur = nx;
#pragma unroll
        for (int d0 = 0; d0 < 4; ++d0) qf[d0] = qn[d0];
    }
#undef ATT_GLOAD
}
__device__ __forceinline__ void mix_phase(const P& p, int gw, int ngw, int lane) {
    const bf16_t* PO = (const bf16_t*)(p.ws + WS_PO); const float* PL = (const float*)(p.ws + WS_PL);
    const bf16_t* CB = (const bf16_t*)(p.ws + WS_CB); const bf16_t* CC = (const bf16_t*)(p.ws + WS_CC); const bf16_t* CH = (const bf16_t*)(p.ws + WS_CH);
    bf16_t* mix = (bf16_t*)(p.ws + WS_XN);
    const int c0 = 8 * lane, hd = lane >> 3;
    float ga[8], gc[8], w0[8], w1[8], w2[8];
#pragma unroll
    for (int e = 0; e < 8; ++e) { ga[e] = p.g_attn_out[c0 + e]; gc[e] = p.g_conv_out[c0 + e]; w0[e] = p.conv_w[c0 + e]; w1[e] = p.conv_w[512 + c0 + e]; w2[e] = p.conv_w[1024 + c0 + e]; }
    auto unpack = [](u32x4 v, float (&f)[8]) { f[0] = __uint_as_float(v.x << 16); f[1] = __uint_as_float(v.x & 0xffff0000u); f[2] = __uint_as_float(v.y << 16); f[3] = __uint_as_float(v.y & 0xffff0000u);
        f[4] = __uint_as_float(v.z << 16); f[5] = __uint_as_float(v.z & 0xffff0000u); f[6] = __uint_as_float(v.w << 16); f[7] = __uint_as_float(v.w & 0xffff0000u); };
    const u32x4 z4 = {0u, 0u, 0u, 0u};
    for (int chunk = gw; chunk < T / 16; chunk += ngw) {
        const int tb = chunk * 16;
        u32x4 po[2][2][3], cn[2][2], cbv[2][2]; float pl[2][2][3];
#define MIX_LOAD(B, TT) do { _Pragma("unroll") for (int k = 0; k < 2; ++k) { _Pragma("unroll") for (int br = 0; br < 3; ++br) { \
            po[B][k][br] = __builtin_nontemporal_load((const u32x4*)(PO + (size_t)br * T * AW + (size_t)((TT) + k) * AW + c0)); pl[B][k][br] = PL[(size_t)br * T * NH + (size_t)((TT) + k) * NH + hd]; } \
            cn[B][k] = __builtin_nontemporal_load((const u32x4*)(CC + (size_t)((TT) + k) * AW + c0)); cbv[B][k] = __builtin_nontemporal_load((const u32x4*)(CB + (size_t)((TT) + k) * AW + c0)); } } while (0)
        MIX_LOAD(0, tb);
        u32x4 cp0 = z4, cp1 = z4;
        if ((tb & (SEQ - 1)) != 0) { cp0 = __builtin_nontemporal_load((const u32x4*)(CC + (size_t)(tb - 2) * AW + c0)); cp1 = __builtin_nontemporal_load((const u32x4*)(CC + (size_t)(tb - 1) * AW + c0)); }
#pragma unroll
        for (int it = 0; it < 8; ++it) { const int t = tb + 2 * it; constexpr int dummy_ = 0; (void)dummy_;
            const int B = it & 1;
            if (it < 7) { if (B == 0) MIX_LOAD(1, t + 2); else MIX_LOAD(0, t + 2); }
            float u[4][8];
            unpack(cp0, u[0]); unpack(cp1, u[1]); unpack(cn[B][0], u[2]); unpack(cn[B][1], u[3]);
#pragma unroll
            for (int k = 0; k < 2; ++k) {
                float o[8], f[8];
                unpack(po[B][k][0], o); unpack(po[B][k][1], f);
#pragma unroll
                for (int e = 0; e < 8; ++e) o[e] += f[e];
                unpack(po[B][k][2], f);
#pragma unroll
                for (int e = 0; e < 8; ++e) o[e] += f[e];
                const float il = 1.0f / (pl[B][k][0] + pl[B][k][1] + pl[B][k][2]); float ss = 0.f;
#pragma unroll
                for (int e = 0; e < 8; ++e) { o[e] *= il; ss += o[e] * o[e]; }
                ss += __shfl_xor(ss, 1); ss += __shfl_xor(ss, 2); ss += __shfl_xor(ss, 4);
                float ri = 1.0f / sqrtf(ss * (1.0f / 64.f) + EPS);
                u32x4 w; w.x = cvtpk(o[0] * ri * ga[0], o[1] * ri * ga[1]); w.y = cvtpk(o[2] * ri * ga[2], o[3] * ri * ga[3]); w.z = cvtpk(o[4] * ri * ga[4], o[5] * ri * ga[5]); w.w = cvtpk(o[6] * ri * ga[6], o[7] * ri * ga[7]);
                *(u32x4*)(mix + (size_t)(t + k) * DM + c0) = w;
                float y[8], a[8];
                unpack(cbv[B][k], a); ss = 0.f;
#pragma unroll
                for (int e = 0; e < 8; ++e) { y[e] = a[e] * (w0[e] * u[k][e] + w1[e] * u[k + 1][e] + w2[e] * u[k + 2][e]); ss += y[e] * y[e]; }
                ss += __shfl_xor(ss, 1); ss += __shfl_xor(ss, 2); ss += __shfl_xor(ss, 4);
                ri = 1.0f / sqrtf(ss * (1.0f / 64.f) + EPS);
                w.x = cvtpk(y[0] * ri * gc[0], y[1] * ri * gc[1]); w.y = cvtpk(y[2] * ri * gc[2], y[3] * ri * gc[3]); w.z = cvtpk(y[4] * ri * gc[4], y[5] * ri * gc[5]); w.w = cvtpk(y[6] * ri * gc[6], y[7] * ri * gc[7]);
                *(u32x4*)(mix + (size_t)(t + k) * DM + 512 + c0) = w;
            }
            cp0 = cn[B][0]; cp1 = cn[B][1];
        }
#undef MIX_LOAD
    }
}
}

__device__ __forceinline__ void route_phase(const P& p, LAS unsigned char* lds, int gw, int ngw, int wave, int lane, unsigned* cnt, pg8::u32x4* rec) {
    typedef short bf16x8 __attribute__((ext_vector_type(8)));
    const bf16_t* h1b = (const bf16_t*)(p.ws + WS_H1);
    const bf16x8* WH = (const bf16x8*)(p.ws + WS_WRH); const bf16x8* WL = (const bf16x8*)(p.ws + WS_WRL);
    LAS float* sc = (LAS float*)(lds + STASH_OFF + wave * 1344);
    const int row = lane & 15, kq = lane >> 4;
    const LAS bf16x8* wl = (const LAS bf16x8*)lds;
    for (int tile = gw; tile < T / 16; tile += ngw) {
        const bf16_t* arow = h1b + (size_t)(tile * 16 + row) * DM + 8 * kq;
        bf16x8 av[32];
#pragma unroll
        for (int ks = 0; ks < 32; ++ks) av[ks] = *(const bf16x8*)(arow + 32 * ks);
#pragma unroll
        for (int j = 0; j < 16; ++j) __builtin_amdgcn_global_load_lds((const unsigned*)((j < 8 ? WH : WL) + (j & 7) * 512 + (int)threadIdx.x), (LAS unsigned*)(lds + (j * 512 + wave * 64) * 16), 16, 0, 0);
        asm volatile("s_waitcnt vmcnt(0)" ::: "memory");
        __syncthreads();
        f32x4 a0 = {0.f, 0.f, 0.f, 0.f}, a1 = {0.f, 0.f, 0.f, 0.f}; float ss = 0.f;
#pragma unroll
        for (int ks = 0; ks < 32; ++ks) { const bf16x8 a = av[ks];
            const bf16x8 bh0 = wl[(ks * 2 + 0) * 64 + lane], bh1 = wl[(ks * 2 + 1) * 64 + lane], bl0 = wl[4096 + (ks * 2 + 0) * 64 + lane], bl1 = wl[4096 + (ks * 2 + 1) * 64 + lane];
#pragma unroll
            for (int j = 0; j < 8; ++j) { const float v = bf2f((unsigned short)a[j]); ss += v * v; }
            a0 = __builtin_amdgcn_mfma_f32_16x16x32_bf16(a, bh0, a0, 0, 0, 0); a0 = __builtin_amdgcn_mfma_f32_16x16x32_bf16(a, bl0, a0, 0, 0, 0);
            a1 = __builtin_amdgcn_mfma_f32_16x16x32_bf16(a, bh1, a1, 0, 0, 0); a1 = __builtin_amdgcn_mfma_f32_16x16x32_bf16(a, bl1, a1, 0, 0, 0);
        }
        ss += __shfl_xor(ss, 16); ss += __shfl_xor(ss, 32);
        const float r = 1.0f / sqrtf(ss * (1.0f / 1024.f) + EPS);
#pragma unroll
        for (int q = 0; q < 4; ++q) { sc[(4 * kq + q) * 21 + row] = a0[q]; if (row < 4) sc[(4 * kq + q) * 21 + 16 + row] = a1[q]; }
        asm volatile("s_waitcnt lgkmcnt(0)" ::: "memory");
        float lg[4], le[16];
#pragma unroll
        for (int e = 0; e < 4; ++e) lg[e] = sc[row * 21 + e] * r + p.b_rg[e];
#pragma unroll
        for (int e = 0; e < 16; ++e) le[e] = sc[row * 21 + 4 + e] * r + p.b_re[e];
        asm volatile("s_waitcnt lgkmcnt(0)" ::: "memory");
        int gi = 0; float gm = lg[0];
#pragma unroll
        for (int e = 1; e < 4; ++e) if (lg[e] > gm) { gm = lg[e]; gi = e; }
        float zs = 0.f;
#pragma unroll
        for (int e = 0; e < 4; ++e) zs += expf(lg[e] - gm);
        const float pg_top = 1.0f / zs;
        float l4[4];
#pragma unroll
        for (int i = 0; i < 4; ++i) l4[i] = gi == 0 ? le[i] : (gi == 1 ? le[4 + i] : (gi == 2 ? le[8 + i] : le[12 + i]));
        int i1 = 0; float m1 = l4[0];
#pragma unroll
        for (int i = 1; i < 4; ++i) if (l4[i] > m1) { m1 = l4[i]; i1 = i; }
        int i2 = -1; float m2 = -INFINITY;
#pragma unroll
        for (int i = 0; i < 4; ++i) if (i != i1 && l4[i] > m2) { m2 = l4[i]; i2 = i; }
        if (i2 < 0) i2 = (i1 + 1) & 3;
        const float t1 = 1.0f / (1.0f + expf(m2 - m1)), t2 = 1.0f - t1;
        const int a = i1 < i2 ? i1 : i2, b = i1 < i2 ? i2 : i1;
        const float ga = pg_top * (a == i1 ? t1 : t2), gb = pg_top * (b == i1 ? t1 : t2);
        const int pi = a == 0 ? b - 1 : (a == 1 ? b + 1 : 5);
        const int bucket = gi * 6 + pi;
        LAS unsigned* lcnt = (LAS unsigned*)(lds + 131072 + 512); LAS unsigned* gbase = lcnt + 32;
        if (threadIdx.x < 32) lcnt[threadIdx.x] = 0u;
        __syncthreads();
        unsigned lrank = 0u;
        if (lane < 16) lrank = __hip_atomic_fetch_add(lcnt + bucket, 1u, __ATOMIC_RELAXED, __HIP_MEMORY_SCOPE_WORKGROUP);
        __syncthreads();
        if (threadIdx.x < NBKT) { const unsigned n = lcnt[threadIdx.x]; gbase[threadIdx.x] = n ? atomicAdd(&cnt[threadIdx.x * 64], n) : 0u; }
        __syncthreads();
        if (lane < 16) { const int t = tile * 16 + row; const int pos = (int)(gbase[bucket] + lrank); rec[(size_t)bucket * T + pos] = (pg8::u32x4){(unsigned)t, __float_as_uint(r * (1.0f / (pg8::F8_SA * pg8::F8_SW1))), __float_as_uint(ga * pg8::F8_SH), __float_as_uint(gb * pg8::F8_SH)}; }
        __syncthreads();
    }
}

__global__ void __launch_bounds__(NWAVES * 64, 2) mk_fwd(P p) {
    extern __shared__ __attribute__((aligned(16))) unsigned char lds[];
    const int tid = threadIdx.x, wave = __builtin_amdgcn_readfirstlane(tid >> 6);
#define lane (opaque(tid) & 63)
    const int G = gridDim.x, gw = blockIdx.x * NWAVES + wave, ngw = G * NWAVES;
    volatile LAS unsigned* MISC = (volatile LAS unsigned*)((LAS unsigned char*)lds + MISC_OFF);
    for (int u = tid; u < 32; u += NWAVES * 64) MISC[u] = 0u;
    __syncthreads();
    XcdBarrier bar = xcd_barrier_post((unsigned*)(p.ws + WS_CTL) + CW_BAR, MISC + 8);
    if (tid == (NWAVES - 1) * 64) { unsigned nl_, nx_; xcd_barrier_complete((unsigned*)(p.ws + WS_CTL) + CW_BAR, bar.x, nl_, nx_); bar.st[0] = nl_; bar.st[1] = nx_; }
#define GRID_BAR() xcd_barrier(bar)
#define GRID_BAR_COPY(LO, HI) do { xcd_arrive(bar); p0_weights(p, L, gw, ngw, wave, lane, (LO), (HI)); xcd_wait(bar); } while (0)
    LAS unsigned char* L = (LAS unsigned char*)lds;
#ifndef PROBE_DUP
#define PROBE_DUP 0
#endif
#define REP(k) for (int rep_ = 0; rep_ < ((PROBE_DUP == (k)) ? 3 : 1); ++rep_)
    REP(1) { p0_prologue(p, L, gw, ngw, wave, lane);
    xcd_arrive(bar); p0_weights(p, L, gw, ngw, wave, lane, 1536, 2048); p0_weights(p, L, gw, ngw, wave, lane, 2560, 2688); p0_late(p, gw, ngw, lane, 0); xcd_wait(bar); }
    REP(2) { { pg8::DenseSched<DM, DM> S; S.init(T, NZ, G, (int)blockIdx.x); S.A = (const char*)(p.ws + WS_XB); S.Bt = (const char*)(p.ws + WS_WIN);
      pg8::EpiZ E{p.ws, p.q_norm, p.k_norm, (const float*)(p.ws + WS_RINVX), L + OUTT_OFF};
      pg8::gemm_phase(L, L + STASH_OFF, S, E); }
    GRID_BAR_COPY(2688, 4736); }
    REP(3) { att::attn_phase<0>(p, L, gw, ngw, wave, lane);
      if (G != 256) p0_late(p, gw, ngw, lane, 1);
    GRID_BAR_COPY(4736, 6784); }
    REP(4) { att::mix_phase(p, gw, ngw, lane);
    xcd_arrive(bar); p0_weights(p, L, gw, ngw, wave, lane, 6784, 8832); if (G == 256) p0_late(p, gw, ngw, lane, 1, 0); xcd_wait(bar); }
    REP(5) { { pg8::DenseSched<DM, DM> S; S.init(T, DM, G, (int)blockIdx.x); S.A = (const char*)(p.ws + WS_XN); S.Bt = (const char*)(p.ws + WS_WOUT);
      pg8::EpiO E{(const bf16_t*)(p.ws + WS_XB), (bf16_t*)(p.ws + WS_H1), p.ws + WS_H1F8};
      pg8::gemm_phase(L, L + STASH_OFF, S, E); }
    xcd_arrive(bar); p0_weights(p, L, gw, ngw, wave, lane, 8832, 10880); if (G == 256) p0_late(p, gw, ngw, lane, 1, 1); xcd_wait(bar); }
    REP(6) { const bool real = (rep_ == ((PROBE_DUP == 6) ? 2 : 0));
      route_phase(p, L, gw, ngw, wave, lane, (unsigned*)(p.ws + WS_CTL) + (real ? CW_CNT : 16384 + 2048 * rep_), real ? (pg8::u32x4*)(p.ws + WS_REC) : (pg8::u32x4*)(p.ws + WS_PO));
    GRID_BAR_COPY(10880, 14976); }
    int total_sr;
    { const unsigned* cnt = (const unsigned*)(p.ws + WS_CTL) + CW_CNT; LAS int* tt = (LAS int*)(L + TT_OFF);
      LAS int* rk = (LAS int*)(L + TT_OFF + MAXTILES * 16);
      if (tid < NBKT) { const int rb = (int)cnt[tid * 64] & 255; int rank = 0;
        for (int b2 = 0; b2 < NBKT; ++b2) { const int r2 = (int)cnt[b2 * 64] & 255; rank += (r2 > rb || (r2 == rb && b2 < tid)) ? 1 : 0; }
        rk[tid] = rb > 0 ? rank : -1; }
      __syncthreads();
      int o_ = 0, R_ = 0, b_ = -1, off_ = 0;
      for (int b2 = 0; b2 < NBKT; ++b2) { const int n = (int)cnt[b2 * 64], nf = n >> 8; if (tid >= o_ && tid < o_ + nf) { b_ = b2; off_ = (tid - o_) * 256; } o_ += nf; R_ += (n & 255) ? 1 : 0; }
      if (tid >= o_ && tid < o_ + R_) { const int r = tid - o_; for (int b2 = 0; b2 < NBKT; ++b2) if (rk[b2] == r) { b_ = b2; off_ = ((int)cnt[b2 * 64] >> 8) * 256; } }
      total_sr = (o_ + R_) * 256;
      if (tid < MAXTILES) { const bool ok_ = b_ >= 0; if (!ok_) { b_ = 0; off_ = 0; } tt[tid * 4] = b_; tt[tid * 4 + 1] = tid * 256 - off_; tt[tid * 4 + 2] = ok_ ? (int)cnt[b_ * 64] : 0; tt[tid * 4 + 3] = 0; }
      __syncthreads(); }
    REP(8) { { pg8::Moe1Sched S; S.init(total_sr, 2048, G, (int)blockIdx.x); S.tail_split(); S.h1b = (const char*)(p.ws + WS_H1F8); S.W13 = (const char*)(p.ws + WS_W13); S.list = (const int*)(p.ws + WS_REC); S.tt = (const LAS int*)(L + TT_OFF);
      pg8::EpiM1 E{p.ws + WS_H, (const pg8::u32x4*)(p.ws + WS_REC)};
      pg8::gemm_phase(L, L + STASH_OFF, S, E); }
      { const int n1 = (total_sr / 256) * 8, r1 = n1 % G, ne1 = G - r1, c = (int)blockIdx.x; int u1 = ne1; if (u1 > 512) u1 = 512;
        pg8::UOrder S; S.A = (const char*)(p.ws + WS_PB); S.Bt = (const char*)(p.ws + WS_WP); S.first = c - r1; S.stride = ne1; S.count = (c >= r1) ? ((c - r1 + ne1 < u1) ? 2 : ((c - r1 < u1) ? 1 : 0)) : 0;
        pg8::EpiU E{p.ws + WS_U, (float*)(p.ws + WS_SSQU), p.g_ple_post};
        pg8::gemm_phase(L, L + STASH_OFF, S, E); }
    GRID_BAR_COPY(2048, 2560); }
    REP(9) { { pg8::Moe2Sched S; S.init(total_sr, DM, G, (int)blockIdx.x); S.tail_split(); S.H = (const char*)(p.ws + WS_H); S.W2 = (const char*)(p.ws + WS_W2); S.tt = (const LAS int*)(L + TT_OFF);
      pg8::EpiM2 E{(const bf16_t*)(p.ws + WS_H1), p.ws + WS_XN, (float*)(p.ws + WS_SSQ2), (const int*)(p.ws + WS_REC), p.ws + WS_H2F8};
      pg8::gemm_phase(L, L + STASH_OFF, S, E); }
      { const int nt_ = total_sr / 256, n1 = nt_ * 8, r1 = n1 % G, ne1 = G - r1; int u1 = ne1; if (u1 > 512) u1 = 512;
        const int n2 = nt_ * 4, r2 = n2 % G, ne2 = G - r2, c = (int)blockIdx.x, rem = 512 - u1;
        pg8::UOrder S; S.A = (const char*)(p.ws + WS_PB); S.Bt = (const char*)(p.ws + WS_WP); S.first = u1 + (c - r2); S.stride = ne2; S.count = (c >= r2 && c - r2 < rem) ? (rem - (c - r2) + ne2 - 1) / ne2 : 0;
        pg8::EpiU E{p.ws + WS_U, (float*)(p.ws + WS_SSQU), p.g_ple_post};
        pg8::gemm_phase(L, L + STASH_OFF, S, E); }
    GRID_BAR(); }
    REP(10) { { pg8::DenseSched<DM, DM, 1> S; S.init(T, DM, G, (int)blockIdx.x); S.A = (const char*)(p.ws + WS_H2F8); S.Bt = (const char*)(p.ws + WS_WG);
      pg8::EpiG E{p.out, (const unsigned char*)(p.ws + WS_H2F8), (const unsigned char*)(p.ws + WS_XN), (const unsigned char*)(p.ws + WS_U), (const float*)(p.ws + WS_SSQ2), (const float*)(p.ws + WS_SSQU), L + OUTT_OFF};
      pg8::gemm_phase(L, L + STASH_OFF, S, E); }
      if (rep_ + 1 < ((PROBE_DUP == 10) ? 3 : 1)) GRID_BAR(); }
}

extern "C" void kernel_launch(void* const* d_in, const int* in_sizes, int n_in, void* d_out, int out_size, void* d_ws, size_t ws_size, hipStream_t stream) {
    static int grid = 0;
    if (grid == 0) {
        int dev = 0, cus = 0, per_cu = 0;
        if (n_in != 22 || out_size != T * DM || ws_size < WS_END) { fprintf(stderr, "kernel_launch: unexpected problem shape / workspace\n"); grid = -1; return; }
        (void)hipGetDevice(&dev);
        (void)hipDeviceGetAttribute(&cus, hipDeviceAttributeMultiprocessorCount, dev);
        (void)hipFuncSetAttribute((const void*)mk_fwd, hipFuncAttributeMaxDynamicSharedMemorySize, LDS_BYTES);
        (void)hipOccupancyMaxActiveBlocksPerMultiprocessor(&per_cu, (const void*)mk_fwd, NWAVES * 64, LDS_BYTES);
        (void)hipGetLastError();
        if (per_cu < 1) { fprintf(stderr, "kernel_launch: occupancy query says %d blocks/CU\n", per_cu); grid = -1; return; }
        grid = cus;
    }
    if (grid < 0) return;
    P p{};
    const float* const* in = (const float* const*)d_in;
    p.x = in[0]; p.p = in[1]; p.g_mix = in[2]; p.w_in = in[3]; p.q_norm = in[4]; p.k_norm = in[5]; p.conv_w = in[6]; p.g_attn_out = in[7]; p.g_conv_out = in[8];
    p.w_out = in[9]; p.g_ffn = in[10]; p.w_rg = in[11]; p.b_rg = in[12]; p.w_re = in[13]; p.b_re = in[14]; p.w1 = in[15]; p.w3 = in[16]; p.w2 = in[17];
    p.g_ple = in[18]; p.w_ple_gate = in[19]; p.w_ple_proj = in[20]; p.g_ple_post = in[21];
    p.out = (float*)d_out; p.ws = (unsigned char*)d_ws;
    for (int i = 0; i < 8; ++i) p.inv_freq[i] = (float)pow(500000.0, -(double)(2 * i) / 16.0);
    (void)hipMemsetAsync((char*)d_ws + WS_CTL, 0, CTL_ZERO_BYTES, stream);
    void* args[] = {&p};
    hipError_t e = hipLaunchCooperativeKernel((const void*)mk_fwd, dim3(grid), dim3(NWAVES * 64), args, LDS_BYTES, stream);
    if (e != hipSuccess) fprintf(stderr, "cooperative launch failed: %s (grid %d)\n", hipGetErrorString(e), grid);
}
```
